# Optimizing an MI355X kernel written in HIP

```python
import jax
import jax.numpy as jnp
from jax import lax
import numpy as np

D_MODEL = 1024
BATCH = 4
SEQ = 4096
DEPTH = 1

GRID_W = 64
CTX_LEN = 256
N_DIR = 2
GDN_HEADS = 8
GDN_DK = 128
GDN_DV = 128
GDN_CHUNK = 64
CONV_K = 3
HGRN_HEADS = 8
HGRN_DK = 128
HGRN_DV = 128
HGRN_CHUNK = 64
D_FF = 4 * D_MODEL
EPS = 1e-6
QKV_W = GDN_HEADS * (2 * GDN_DK + GDN_DV)
IN_WIDTHS = (
    QKV_W,
    GDN_HEADS * GDN_DV,
    N_DIR * GDN_HEADS,
    N_DIR * GDN_HEADS,
    N_DIR * HGRN_HEADS * HGRN_DK,
    HGRN_HEADS * HGRN_DK,
    HGRN_HEADS * HGRN_DV,
    HGRN_HEADS * HGRN_DV,
    2 * D_MODEL,
)
IN_TOTAL = sum(IN_WIDTHS)

kernel_name = "hybrid_gdn_hgrn2_dit_block"


def _rms(t, g):
    tf = t.astype(jnp.float32)
    tf = tf * lax.rsqrt(jnp.mean(tf * tf, axis=-1, keepdims=True) + EPS)
    return (tf * g.astype(jnp.float32)).astype(t.dtype)


def _l2n(t):
    return t * lax.rsqrt(jnp.sum(t * t, axis=-1, keepdims=True) + EPS)


def _modulation(cond, w_ada, b_ada):
    m = jax.nn.silu(cond) @ w_ada + b_ada
    return jnp.split(m[..., None, :], 6, axis=-1)


def _to_chunks(t, chunk):
    b, T, h = t.shape[:3]
    t = t.reshape(b, T // chunk, chunk, h, *t.shape[3:])
    return jnp.moveaxis(t, 3, 1)


def _from_chunks(o):
    n, b, h, c, d = o.shape
    return jnp.transpose(o, (1, 0, 3, 2, 4)).reshape(b, n * c, h, d)


def _gdn_scan(q, k, v, log_a, beta, s0):
    C = GDN_CHUNK
    dv = v.shape[-1]
    qc, kc, vc = _to_chunks(q, C), _to_chunks(k, C), _to_chunks(v, C)
    g = jnp.cumsum(_to_chunks(log_a, C), axis=-1)
    bc = _to_chunks(beta, C)
    incl = jnp.tril(jnp.ones((C, C), bool))
    strict = jnp.tril(jnp.ones((C, C), bool), -1)
    L = jnp.exp(jnp.where(incl, g[..., :, None] - g[..., None, :], -jnp.inf))
    A = jnp.where(strict, bc[..., :, None] * jnp.einsum('bhnik,bhnjk->bhnij', kc, kc) * L, 0.0)
    rhs = jnp.concatenate([vc * bc[..., None], kc * (bc * jnp.exp(g))[..., None]], axis=-1)
    sol = lax.linalg.triangular_solve(A + jnp.eye(C, dtype=A.dtype), rhs,
                                      left_side=True, lower=True, unit_diagonal=True)
    u, w = sol[..., :dv], sol[..., dv:]
    attn = jnp.where(incl, jnp.einsum('bhnik,bhnjk->bhnij', qc, kc) * L, 0.0)
    qg = qc * jnp.exp(g)[..., None]
    g_last = g[..., -1:]
    kdec = kc * jnp.exp(g_last - g)[..., None]
    dlast = jnp.exp(g_last[..., 0])

    def step(S, xs):
        u_n, w_n, attn_n, qg_n, kdec_n, d_n = xs
        v_new = u_n - jnp.einsum('bhck,bhkv->bhcv', w_n, S)
        o = jnp.einsum('bhck,bhkv->bhcv', qg_n, S) + jnp.einsum('bhij,bhjv->bhiv', attn_n, v_new)
        S = d_n[..., None, None] * S + jnp.einsum('bhck,bhcv->bhkv', kdec_n, v_new)
        return S, o

    xs = tuple(jnp.moveaxis(t, 2, 0) for t in (u, w, attn, qg, kdec, dlast))
    s_fin, o = lax.scan(step, s0, xs)
    return _from_chunks(o), s_fin


def _hgrn2_scan(q, k, v, log_f, s0):
    C = HGRN_CHUNK
    qc, kc, vc = _to_chunks(q, C), _to_chunks(k, C), _to_chunks(v, C)
    b = jnp.cumsum(_to_chunks(log_f, C), axis=3)
    incl = jnp.tril(jnp.ones((C, C), bool))[:, :, None]

    def step(S, xs):
        q_n, k_n, v_n, b_n = xs
        o_inter = jnp.einsum('bhck,bhkv->bhcv', q_n * jnp.exp(b_n), S)
        dec = jnp.exp(jnp.where(incl, b_n[:, :, :, None, :] - b_n[:, :, None, :, :], -jnp.inf))
        a = jnp.einsum('bhtk,bhsk,bhtsk->bhts', q_n, k_n, dec)
        o = o_inter + jnp.einsum('bhts,bhsv->bhtv', a, v_n)
        b_last = b_n[:, :, -1:]
        S = jnp.exp(b_last[:, :, 0])[..., None] * S + jnp.einsum(
            'bhsk,bhsv->bhkv', k_n * jnp.exp(b_last - b_n), v_n)
        return S, o

    xs = tuple(jnp.moveaxis(t, 2, 0) for t in (qc, kc, vc, b))
    s_fin, o = lax.scan(step, s0, xs)
    return _from_chunks(o), s_fin


def _bidir(scan_fn, fwd_args, bwd_args, s0):
    o_f, s_f = scan_fn(*fwd_args, s0[0])
    o_b, s_b = scan_fn(*(jnp.flip(t, 1) for t in bwd_args), s0[1])
    return o_f + jnp.flip(o_b, 1), jnp.stack([s_f, s_b])


def _conv_latent(t, w):
    B, T, Cc = t.shape
    rows = T // GRID_W
    y = lax.conv_general_dilated(
        t.reshape(B, rows, GRID_W, Cc), w[:, :, None, :].astype(t.dtype),
        window_strides=(1, 1), padding='SAME',
        dimension_numbers=('NHWC', 'HWIO', 'NHWC'), feature_group_count=Cc)
    return jax.nn.silu(y.reshape(B, T, Cc))


def _conv_context(t, w):
    taps = w[CONV_K // 2].astype(t.dtype)
    pad = CONV_K // 2
    T = t.shape[1]
    tp = jnp.pad(t, ((0, 0), (pad, pad), (0, 0)))
    y = sum(taps[j] * tp[:, j:j + T] for j in range(CONV_K))
    return jax.nn.silu(y)


def _mixer_core(h, conv_fn, s0_a, s0_b, w_in, conv_w, a_log, dt_bias, lb):
    B, T, _ = h.shape
    f32 = jnp.float32
    z = h @ w_in
    qkv, g_a, a_in, b_in, f_in, q_b, i_b, g_b, mg = jnp.split(
        z, np.cumsum(IN_WIDTHS)[:-1].tolist(), axis=-1)
    qkv = conv_fn(qkv, conv_w).astype(f32)
    q_a, k_a, v_a = jnp.split(qkv, [GDN_HEADS * GDN_DK, 2 * GDN_HEADS * GDN_DK], axis=-1)
    q_a = _l2n(q_a.reshape(B, T, GDN_HEADS, GDN_DK)) * GDN_DK ** -0.5
    k_a = _l2n(k_a.reshape(B, T, GDN_HEADS, GDN_DK))
    v_a = v_a.reshape(B, T, GDN_HEADS, GDN_DV)
    a_in = a_in.astype(f32).reshape(B, T, N_DIR, GDN_HEADS)
    log_a = -jnp.exp(a_log.astype(f32)) * jax.nn.softplus(a_in + dt_bias.astype(f32))
    beta = jax.nn.sigmoid(b_in.astype(f32).reshape(B, T, N_DIR, GDN_HEADS))
    o_a, s_a = _bidir(_gdn_scan,
                      (q_a, k_a, v_a, log_a[:, :, 0], beta[:, :, 0]),
                      (q_a, k_a, v_a, log_a[:, :, 1], beta[:, :, 1]), s0_a)
    f_z = f_in.astype(f32).reshape(B, T, N_DIR, HGRN_HEADS, HGRN_DK)
    lb = lb.reshape(N_DIR, HGRN_HEADS, HGRN_DK)
    log_f = jnp.log(lb + (1.0 - lb) * jax.nn.sigmoid(f_z))
    k_b = (1.0 - lb) * jax.nn.sigmoid(-f_z)
    q_bh = jax.nn.silu(q_b.astype(f32)).reshape(B, T, HGRN_HEADS, HGRN_DK) * HGRN_DK ** -0.5
    v_bh = i_b.astype(f32).reshape(B, T, HGRN_HEADS, HGRN_DV)
    o_b, s_b = _bidir(_hgrn2_scan,
                      (q_bh, k_b[:, :, 0], v_bh, log_f[:, :, 0]),
                      (q_bh, k_b[:, :, 1], v_bh, log_f[:, :, 1]), s0_b)
    return o_a.astype(h.dtype), o_b.astype(h.dtype), g_a, g_b, mg, s_a, s_b


def _mixer_out(o_a, o_b, g_a, g_b, mg, gdn_norm_w, hgrn_norm_w, w_branch_a, w_branch_b, w_out):
    B, T = o_a.shape[:2]
    y_a = (_rms(o_a, gdn_norm_w) * jax.nn.silu(g_a.reshape(B, T, GDN_HEADS, GDN_DV))).reshape(B, T, -1)
    y_b = (_rms(o_b, hgrn_norm_w) * jax.nn.silu(g_b.reshape(B, T, HGRN_HEADS, HGRN_DV))).reshape(B, T, -1)
    gate_a, gate_b = jnp.split(jax.nn.sigmoid(mg), 2, axis=-1)
    return (gate_a * (y_a @ w_branch_a) + gate_b * (y_b @ w_branch_b)) @ w_out


def _sq_relu_mlp(h, w1, w2):
    return jnp.square(jax.nn.relu(h @ w1)) @ w2


def setup_inputs(seed: int = 0) -> dict:
    key = jax.random.key(seed)
    ks = jax.random.split(key, 20)
    f32 = jnp.float32

    def nrm(k, shape, scale):
        return scale * jax.random.normal(k, shape, f32)

    dt = jnp.exp(jax.random.uniform(ks[10], (DEPTH, N_DIR, GDN_HEADS), f32,
                                    float(np.log(1e-3)), float(np.log(1e-1))))
    return {
        "x": nrm(ks[0], (BATCH, SEQ, D_MODEL), 1.0),
        "c": nrm(ks[1], (BATCH, D_MODEL), 1.0),
        "ctx": nrm(ks[2], (BATCH, CTX_LEN, D_MODEL), 1.0),
        "c_ctx": nrm(ks[3], (D_MODEL,), 1.0),
        "w_ada": nrm(ks[4], (DEPTH, D_MODEL, 6 * D_MODEL), 0.5 * D_MODEL ** -0.5),
        "b_ada": nrm(ks[5], (DEPTH, 6 * D_MODEL), 0.02),
        "norm_g": 1.0 + nrm(ks[6], (DEPTH, 4, D_MODEL), 0.02),
        "w_in": nrm(ks[7], (DEPTH, D_MODEL, IN_TOTAL), D_MODEL ** -0.5),
        "conv_w": nrm(ks[8], (DEPTH, CONV_K, CONV_K, QKV_W), 1.0 / CONV_K),
        "gdn_a_log": jnp.log(jax.random.uniform(ks[9], (DEPTH, N_DIR, GDN_HEADS), f32, 1.0, 16.0)),
        "gdn_dt_bias": dt + jnp.log(-jnp.expm1(-dt)),
        "gdn_norm_w": 1.0 + nrm(ks[11], (DEPTH, GDN_DV), 0.02),
        "hgrn_lb_logits": nrm(ks[12], (DEPTH + 1, N_DIR, HGRN_HEADS * HGRN_DK), 0.5),
        "hgrn_norm_w": 1.0 + nrm(ks[13], (DEPTH, HGRN_DV), 0.02),
        "w_branch_a": nrm(ks[14], (DEPTH, GDN_HEADS * GDN_DV, D_MODEL), (GDN_HEADS * GDN_DV) ** -0.5),
        "w_branch_b": nrm(ks[15], (DEPTH, HGRN_HEADS * HGRN_DV, D_MODEL), (HGRN_HEADS * HGRN_DV) ** -0.5),
        "w_out": nrm(ks[16], (DEPTH, D_MODEL, D_MODEL), D_MODEL ** -0.5),
        "w_mlp_in": nrm(ks[17], (DEPTH, D_MODEL, D_FF), D_MODEL ** -0.5),
        "w_mlp_out": nrm(ks[18], (DEPTH, D_FF, D_MODEL), D_FF ** -0.5),
    }


def reference(x, c, ctx, c_ctx, w_ada, b_ada, norm_g, w_in, conv_w, gdn_a_log, gdn_dt_bias,
              gdn_norm_w, hgrn_lb_logits, hgrn_norm_w, w_branch_a, w_branch_b, w_out,
              w_mlp_in, w_mlp_out):
    B = x.shape[0]
    f32 = jnp.float32
    lb_all = jnp.cumsum(jax.nn.softmax(hgrn_lb_logits.astype(f32), axis=0), axis=0)
    zeros_a = jnp.zeros((N_DIR, B, GDN_HEADS, GDN_DK, GDN_DV), f32)
    zeros_b = jnp.zeros((N_DIR, B, HGRN_HEADS, HGRN_DK, HGRN_DV), f32)
    for l in range(DEPTH):
        sh_mx, sc_mx, gt_mx, sh_ff, sc_ff, gt_ff = _modulation(c, w_ada[l], b_ada[l])
        csh_mx, csc_mx, cgt_mx, csh_ff, csc_ff, cgt_ff = _modulation(c_ctx, w_ada[l], b_ada[l])
        mix_p = (w_in[l], conv_w[l], gdn_a_log[l], gdn_dt_bias[l], lb_all[l])
        out_p = (gdn_norm_w[l], hgrn_norm_w[l], w_branch_a[l], w_branch_b[l], w_out[l])
        hc = _rms(ctx, norm_g[l, 0]) * (1.0 + csc_mx) + csh_mx
        ca, cb, cga, cgb, cmg, s_a, s_b = _mixer_core(hc, _conv_context, zeros_a, zeros_b, *mix_p)
        hx = _rms(x, norm_g[l, 0]) * (1.0 + sc_mx) + sh_mx
        xa, xb, xga, xgb, xmg, _, _ = _mixer_core(hx, _conv_latent, s_a, s_b, *mix_p)
        x = x + gt_mx * _rms(_mixer_out(xa, xb, xga, xgb, xmg, *out_p), norm_g[l, 1])
        hx = _rms(x, norm_g[l, 2]) * (1.0 + sc_ff) + sh_ff
        x = x + gt_ff * _rms(_sq_relu_mlp(hx, w_mlp_in[l], w_mlp_out[l]), norm_g[l, 3])
        if l < DEPTH - 1:
            ctx = ctx + cgt_mx * _rms(_mixer_out(ca, cb, cga, cgb, cmg, *out_p), norm_g[l, 1])
            hc = _rms(ctx, norm_g[l, 2]) * (1.0 + csc_ff) + csh_ff
            ctx = ctx + cgt_ff * _rms(_sq_relu_mlp(hc, w_mlp_in[l], w_mlp_out[l]), norm_g[l, 3])
    return x
```

```cpp
#include <hip/hip_runtime.h>
#include <stdint.h>
#include <stddef.h>
#include <cstdio>
#ifndef MODE
#define MODE 2
#endif
#ifndef DBG_STAGE
#define DBG_STAGE 4
#endif
namespace nv {
constexpr int D = 1024, T = 4096, CT = 256, NB = 4, H = 8, DK = 128, INT = 11296, ROWS = CT + T, FF = 4096;
constexpr float EPS = 1e-6f;
constexpr int C_QKV = 0, C_GA = 3072, C_AIN = 4096, C_BIN = 4112, C_FIN = 4128, C_QB = 6176, C_IB = 7200, C_GB = 8224, C_MG = 9248;

__device__ __forceinline__ float sigm(float x) { return 1.f / (1.f + expf(-x)); }
__device__ __forceinline__ float siluf(float x) { return x / (1.f + expf(-x)); }
__device__ __forceinline__ float softplusf(float x) { return fmaxf(x, 0.f) + log1pf(expf(-fabsf(x))); }

__device__ __forceinline__ float block_sum256(float v, float* red) {
#pragma unroll
    for (int o = 32; o >= 1; o >>= 1) v += __shfl_xor(v, o);
    const int w = threadIdx.x >> 6;
    __syncthreads();
    if ((threadIdx.x & 63) == 0) red[w] = v;
    __syncthreads();
    return red[0] + red[1] + red[2] + red[3];
}

__global__ __launch_bounds__(256) void k_mod(const float* c, const float* c_ctx, const float* w_ada, const float* b_ada, float* mod) {
    __shared__ float s[5][D];
    for (int i = threadIdx.x; i < 5 * D; i += 256) { const int r = i / D, k = i % D; const float x = r < 4 ? c[r * D + k] : c_ctx[k]; s[r][k] = siluf(x); }
    __syncthreads();
    const int n = blockIdx.x * 256 + threadIdx.x;
    float a0 = 0, a1 = 0, a2 = 0, a3 = 0, a4 = 0;
    for (int k = 0; k < D; ++k) { const float w = w_ada[(size_t)k * 6 * D + n]; a0 += s[0][k] * w; a1 += s[1][k] * w; a2 += s[2][k] * w; a3 += s[3][k] * w; a4 += s[4][k] * w; }
    const float b = b_ada[n];
    mod[0 * 6 * D + n] = a0 + b; mod[1 * 6 * D + n] = a1 + b; mod[2 * 6 * D + n] = a2 + b; mod[3 * 6 * D + n] = a3 + b; mod[4 * 6 * D + n] = a4 + b;
}
__global__ void k_lb(const float* logits, float* lb) {
    const int i = blockIdx.x * blockDim.x + threadIdx.x; if (i >= 2 * D) return;
    const float l0 = logits[i], l1 = logits[2 * D + i], m = fmaxf(l0, l1), e0 = expf(l0 - m), e1 = expf(l1 - m);
    lb[i] = e0 / (e0 + e1);
}
__global__ __launch_bounds__(256) void k_rms_mod(const float* in, float* out, const float* g, const float* modrow, int sh_off, int sc_off) {
    __shared__ float red[4];
    const float* x = in + (size_t)blockIdx.x * D; float* o = out + (size_t)blockIdx.x * D;
    float v[4], ss = 0;
#pragma unroll
    for (int j = 0; j < 4; ++j) { v[j] = x[threadIdx.x + 256 * j]; ss += v[j] * v[j]; }
    const float tot = block_sum256(ss, red), inv = 1.0f / sqrtf(tot / D + EPS);
#pragma unroll
    for (int j = 0; j < 4; ++j) { const int n = threadIdx.x + 256 * j; o[n] = (v[j] * inv * g[n]) * (1.f + modrow[sc_off + n]) + modrow[sh_off + n]; }
}
__global__ __launch_bounds__(256) void k_gemm(const float* A, int lda, const float* B, int ldb, float* C, int ldc, int M, int N, int K) {
    __shared__ float As[16][128 + 4];
    __shared__ float Bs[16][64 + 4];
    const int tx = threadIdx.x & 15, ty = threadIdx.x >> 4, m0 = blockIdx.y * 128, n0 = blockIdx.x * 64;
    float acc[8][4];
#pragma unroll
    for (int i = 0; i < 8; ++i)
#pragma unroll
        for (int j = 0; j < 4; ++j) acc[i][j] = 0.f;
    for (int k0 = 0; k0 < K; k0 += 16) {
#pragma unroll
        for (int i = 0; i < 8; ++i) { const int idx = threadIdx.x + i * 256, m = idx >> 4, k = idx & 15; As[k][m] = (m0 + m < M) ? A[(size_t)(m0 + m) * lda + k0 + k] : 0.f; }
#pragma unroll
        for (int i = 0; i < 4; ++i) { const int idx = threadIdx.x + i * 256, k = idx >> 6, n = idx & 63; Bs[k][n] = (n0 + n < N) ? B[(size_t)(k0 + k) * ldb + n0 + n] : 0.f; }
        __syncthreads();
#pragma unroll
        for (int k = 0; k < 16; ++k) {
            float a[8], b[4];
#pragma unroll
            for (int i = 0; i < 8; ++i) a[i] = As[k][ty * 8 + i];
#pragma unroll
            for (int j = 0; j < 4; ++j) b[j] = Bs[k][tx * 4 + j];
#pragma unroll
            for (int i = 0; i < 8; ++i)
#pragma unroll
                for (int j = 0; j < 4; ++j) acc[i][j] += a[i] * b[j];
        }
        __syncthreads();
    }
#pragma unroll
    for (int i = 0; i < 8; ++i)
#pragma unroll
        for (int j = 0; j < 4; ++j) { const int m = m0 + ty * 8 + i, n = n0 + tx * 4 + j; if (m < M && n < N) C[(size_t)m * ldc + n] = acc[i][j]; }
}
__global__ void k_conv(const float* zq, const float* w, float* out) {
    const size_t i = (size_t)blockIdx.x * blockDim.x + threadIdx.x; if (i >= (size_t)ROWS * 3072) return;
    const int row = (int)(i / 3072), ch = (int)(i % 3072);
    float y = 0.f;
    if (row < CT) {
#pragma unroll
        for (int j = 0; j < 3; ++j) { const int t = row + j - 1; if (t >= 0 && t < CT) y += w[(1 * 3 + j) * 3072 + ch] * zq[(size_t)t * 3072 + ch]; }
    } else {
        const int t = row - CT, r = t >> 6, c = t & 63;
#pragma unroll
        for (int dy = 0; dy < 3; ++dy)
#pragma unroll
            for (int dx = 0; dx < 3; ++dx) { const int rr = r + dy - 1, cc = c + dx - 1; if (rr >= 0 && rr < 64 && cc >= 0 && cc < 64) y += w[(dy * 3 + dx) * 3072 + ch] * zq[(size_t)(CT + rr * 64 + cc) * 3072 + ch]; }
    }
    out[i] = siluf(y);
}
__global__ __launch_bounds__(256) void k_l2n(float* qkvc) {
    const int gw = blockIdx.x * 4 + (threadIdx.x >> 6), lane = threadIdx.x & 63; if (gw >= ROWS * 16) return;
    const int row = gw >> 4, hh = gw & 15;
    float* p = qkvc + (size_t)row * 3072 + hh * 128;
    const float a = p[lane], b = p[lane + 64]; float s = a * a + b * b;
#pragma unroll
    for (int o = 32; o >= 1; o >>= 1) s += __shfl_xor(s, o);
    const float inv = (1.0f / sqrtf(s + EPS)) * (hh < 8 ? 0.08838834764831845f : 1.0f);
    p[lane] = a * inv; p[lane + 64] = b * inv;
}
__global__ void k_gates(const float* zab, const float* a_log, const float* dt_bias, float* la, float* be) {
    const int i = blockIdx.x * blockDim.x + threadIdx.x; if (i >= ROWS * 16) return;
    const int row = i >> 4, j = i & 15;
    la[i] = -expf(a_log[j]) * softplusf(zab[row * 32 + j] + dt_bias[j]);
    be[i] = sigm(zab[row * 32 + 16 + j]);
}
__global__ __launch_bounds__(128) void k_gdn_scan(const float* qkvc, const float* la, const float* be, float* o) {
    const int h = blockIdx.x & 7, dir = blockIdx.x >> 3, v = threadIdx.x;
    __shared__ float sq[2][128], sk[2][128];
    float S[128];
#pragma unroll
    for (int k = 0; k < 128; ++k) S[k] = 0.f;
    for (int s = 0; s < ROWS; ++s) {
        const int row = dir == 0 ? s : (s < CT ? CT - 1 - s : ROWS - 1 - (s - CT));
        const float* r = qkvc + (size_t)row * 3072 + h * 128; const int buf = s & 1;
        sq[buf][v] = r[v]; sk[buf][v] = r[1024 + v]; const float vv = r[2048 + v];
        const float a = expf(la[row * 16 + dir * 8 + h]), b = be[row * 16 + dir * 8 + h];
        __syncthreads();
        float ks = 0.f;
#pragma unroll
        for (int k = 0; k < 128; ++k) ks += sk[buf][k] * S[k];
        const float delta = b * (vv - a * ks); float ov = 0.f;
#pragma unroll
        for (int k = 0; k < 128; ++k) { S[k] = a * S[k] + sk[buf][k] * delta; ov += sq[buf][k] * S[k]; }
        if (row >= CT) atomicAdd(&o[(size_t)(row - CT) * 1024 + h * 128 + v], ov);
    }
}
__global__ __launch_bounds__(128) void k_hgrn_scan(const float* zh, const float* lb, float* o) {
    const int h = blockIdx.x & 7, dir = blockIdx.x >> 3, v = threadIdx.x;
    __shared__ float sq[2][128], sk[2][128], sf[2][128];
    const float lbv = lb[dir * 1024 + h * 128 + v];
    float S[128];
#pragma unroll
    for (int k = 0; k < 128; ++k) S[k] = 0.f;
    for (int s = 0; s < ROWS; ++s) {
        const int row = dir == 0 ? s : (s < CT ? CT - 1 - s : ROWS - 1 - (s - CT));
        const float* r = zh + (size_t)row * 4096; const int buf = s & 1;
        const float fz = r[dir * 1024 + h * 128 + v];
        sf[buf][v] = lbv + (1.f - lbv) * sigm(fz); sk[buf][v] = (1.f - lbv) * sigm(-fz);
        sq[buf][v] = siluf(r[2048 + h * 128 + v]) * 0.08838834764831845f; const float vv = r[3072 + h * 128 + v];
        __syncthreads();
        float ov = 0.f;
#pragma unroll
        for (int k = 0; k < 128; ++k) { S[k] = sf[buf][k] * S[k] + sk[buf][k] * vv; ov += sq[buf][k] * S[k]; }
        if (row >= CT) atomicAdd(&o[(size_t)(row - CT) * 1024 + h * 128 + v], ov);
    }
}
__global__ __launch_bounds__(256) void k_mixer_y(const float* o, const float* g, int ldg, const float* w, float* y) {
    const int gw = blockIdx.x * 4 + (threadIdx.x >> 6), lane = threadIdx.x & 63; if (gw >= T * 8) return;
    const int t = gw >> 3, h = gw & 7;
    const float* p = o + (size_t)t * 1024 + h * 128; const float a = p[lane], b = p[lane + 64]; float s = a * a + b * b;
#pragma unroll
    for (int off = 32; off >= 1; off >>= 1) s += __shfl_xor(s, off);
    const float inv = 1.0f / sqrtf(s / 128.f + EPS);
    const float* gp = g + (size_t)t * ldg + h * 128; float* yp = y + (size_t)t * 1024 + h * 128;
    yp[lane] = (a * inv * w[lane]) * siluf(gp[lane]); yp[lane + 64] = (b * inv * w[lane + 64]) * siluf(gp[lane + 64]);
}
__global__ void k_merge(const float* pa, const float* pb, const float* mg, float* m) {
    const size_t i = (size_t)blockIdx.x * blockDim.x + threadIdx.x; if (i >= (size_t)T * D) return;
    const size_t t = i / D; const int n = (int)(i % D);
    m[i] = sigm(mg[t * 2048 + n]) * pa[i] + sigm(mg[t * 2048 + 1024 + n]) * pb[i];
}
__global__ __launch_bounds__(256) void k_resid(const float* xin, const float* r, const float* g, const float* modrow, int gt_off, float* xo) {
    __shared__ float red[4];
    const size_t base = (size_t)blockIdx.x * D;
    float v[4], ss = 0;
#pragma unroll
    for (int j = 0; j < 4; ++j) { v[j] = r[base + threadIdx.x + 256 * j]; ss += v[j] * v[j]; }
    const float tot = block_sum256(ss, red), inv = 1.0f / sqrtf(tot / D + EPS);
#pragma unroll
    for (int j = 0; j < 4; ++j) { const int n = threadIdx.x + 256 * j; xo[base + n] = xin[base + n] + modrow[gt_off + n] * (v[j] * inv * g[n]); }
}
__global__ void k_relu2(float* p, size_t n) { const size_t i = (size_t)blockIdx.x * blockDim.x + threadIdx.x; if (i < n) { const float x = fmaxf(p[i], 0.f); p[i] = x * x; } }
}

struct Ins {
    const float *x, *c, *ctx, *c_ctx, *w_ada, *b_ada, *norm_g, *w_in, *conv_w, *a_log, *dt_bias, *gdn_nw, *lb_logits, *hgrn_nw, *w_ba, *w_bb, *w_out, *w1, *w2;
};
static inline Ins get_ins(void* const* d_in) {
    Ins I; const float** p = (const float**)&I; for (int i = 0; i < 19; ++i) p[i] = (const float*)d_in[i]; return I;
}
static inline void nv_gemm(const float* A, int lda, const float* B, int ldb, float* C, int ldc, int M, int N, int K, hipStream_t s) {
    dim3 grid((N + 63) / 64, (M + 127) / 128);
    hipLaunchKernelGGL(nv::k_gemm, grid, dim3(256), 0, s, A, lda, B, ldb, C, ldc, M, N, K);
}
struct OB { float *mod, *lb, *hb, *zab, *la, *be, *zbuf, *qkvc, *oa, *ob, *ya, *yb, *mbuf, *rbuf; };
static inline bool ob_carve(OB& B, char* base, size_t avail, int stop = 99) {
    using namespace nv; size_t off = 0;
    auto carve = [&](size_t bytes) { float* p = (float*)(base + off); off += (bytes + 255) & ~(size_t)255; return p; };
    B.mod = carve(5 * 6 * D * 4); B.lb = carve(2 * D * 4);
    B.hb = carve((size_t)ROWS * D * 4);
    B.zab = carve((size_t)ROWS * 32 * 4); B.la = carve((size_t)ROWS * 16 * 4); B.be = carve((size_t)ROWS * 16 * 4);
    B.oa = carve((size_t)T * D * 4); B.ob = carve((size_t)T * D * 4);
    B.zbuf = carve((size_t)ROWS * 4096 * 4); if (stop == 1 || stop == 4) return off <= avail;
    B.qkvc = carve((size_t)ROWS * 3072 * 4); if (stop == 2 || stop == 3) return off <= avail;
    B.ya = carve((size_t)T * D * 4); B.yb = carve((size_t)T * D * 4);
    B.mbuf = carve((size_t)T * D * 4); B.rbuf = carve((size_t)T * D * 4);
    return off <= avail;
}
static void oracle_pre(const OB& B, const Ins& I, hipStream_t stream) {
    using namespace nv;
    hipLaunchKernelGGL(k_mod, dim3(6 * D / 256), dim3(256), 0, stream, I.c, I.c_ctx, I.w_ada, I.b_ada, B.mod);
    hipLaunchKernelGGL(k_lb, dim3(2 * D / 256), dim3(256), 0, stream, I.lb_logits, B.lb);
}
static void oracle_batch(const OB& B, int b, int stop, const Ins& I, float* out, hipStream_t stream) {
    using namespace nv;
    const float* xb = I.x + (size_t)b * T * D; const float* cb = I.ctx + (size_t)b * CT * D; float* outb = out + (size_t)b * T * D;
    const float* modb = B.mod + (size_t)b * 6 * D; const float* modc = B.mod + (size_t)4 * 6 * D;
    float *hb = B.hb, *zbuf = B.zbuf, *qkvc = B.qkvc, *zab = B.zab, *la = B.la, *be = B.be, *oa = B.oa, *ob = B.ob, *ya = B.ya, *yb = B.yb, *mbuf = B.mbuf, *rbuf = B.rbuf;
    hipLaunchKernelGGL(k_rms_mod, dim3(CT), dim3(256), 0, stream, cb, hb, I.norm_g, modc, 0, D);
    hipLaunchKernelGGL(k_rms_mod, dim3(T), dim3(256), 0, stream, xb, hb + (size_t)CT * D, I.norm_g, modb, 0, D);
    if (stop != 4) {
        nv_gemm(hb, D, I.w_in + C_QKV, INT, zbuf, 3072, ROWS, 3072, D, stream);
        nv_gemm(hb, D, I.w_in + C_AIN, INT, zab, 32, ROWS, 32, D, stream);
        hipLaunchKernelGGL(k_gates, dim3(ROWS * 16 / 256), dim3(256), 0, stream, zab, I.a_log, I.dt_bias, la, be);
        if (stop == 1) return;
        hipLaunchKernelGGL(k_conv, dim3((unsigned)(((size_t)ROWS * 3072 + 255) / 256)), dim3(256), 0, stream, zbuf, I.conv_w, qkvc);
        hipLaunchKernelGGL(k_l2n, dim3(ROWS * 16 / 4), dim3(256), 0, stream, qkvc);
        if (stop == 2) return;
        (void)hipMemsetAsync(oa, 0, (size_t)T * D * 4, stream);
        hipLaunchKernelGGL(k_gdn_scan, dim3(16), dim3(128), 0, stream, qkvc, la, be, oa);
        if (stop == 3) return;
    }
    nv_gemm(hb, D, I.w_in + C_FIN, INT, zbuf, 4096, ROWS, 4096, D, stream);
    (void)hipMemsetAsync(ob, 0, (size_t)T * D * 4, stream);
    hipLaunchKernelGGL(k_hgrn_scan, dim3(16), dim3(128), 0, stream, zbuf, B.lb, ob);
    if (stop == 4) return;
    float* zga = zbuf; float* zgb = zbuf + (size_t)T * D; float* zmg = zbuf + (size_t)2 * T * D;
    const float* hl = hb + (size_t)CT * D;
    nv_gemm(hl, D, I.w_in + C_GA, INT, zga, D, T, D, D, stream);
    nv_gemm(hl, D, I.w_in + C_GB, INT, zgb, D, T, D, D, stream);
    nv_gemm(hl, D, I.w_in + C_MG, INT, zmg, 2 * D, T, 2 * D, D, stream);
    hipLaunchKernelGGL(k_mixer_y, dim3(T * 8 / 4), dim3(256), 0, stream, oa, zga, D, I.gdn_nw, ya);
    hipLaunchKernelGGL(k_mixer_y, dim3(T * 8 / 4), dim3(256), 0, stream, ob, zgb, D, I.hgrn_nw, yb);
    if (stop == 5) return;
    float* pa = qkvc; float* pb = qkvc + (size_t)T * D;
    nv_gemm(ya, D, I.w_ba, D, pa, D, T, D, D, stream);
    nv_gemm(yb, D, I.w_bb, D, pb, D, T, D, D, stream);
    hipLaunchKernelGGL(k_merge, dim3(T * D / 256), dim3(256), 0, stream, pa, pb, zmg, mbuf);
    if (stop == 6) return;
    nv_gemm(mbuf, D, I.w_out, D, rbuf, D, T, D, D, stream);
    hipLaunchKernelGGL(k_resid, dim3(T), dim3(256), 0, stream, xb, rbuf, I.norm_g + D, modb, 2 * D, outb);
    hipLaunchKernelGGL(k_rms_mod, dim3(T), dim3(256), 0, stream, outb, ya, I.norm_g + 2 * D, modb, 3 * D, 4 * D);
    if (stop == 7) return;
    nv_gemm(ya, D, I.w1, FF, zbuf, FF, T, FF, D, stream);
    hipLaunchKernelGGL(k_relu2, dim3((unsigned)((size_t)T * FF / 256)), dim3(256), 0, stream, zbuf, (size_t)T * FF);
    nv_gemm(zbuf, FF, I.w2, D, yb, D, T, D, FF, stream);
    hipLaunchKernelGGL(k_resid, dim3(T), dim3(256), 0, stream, outb, yb, I.norm_g + 3 * D, modb, 5 * D, outb);
}
namespace nv {
__host__ __device__ inline int fast_row(int b, int r) { return r < CT ? NB * T + b * CT + r : b * T + (r - CT); }
template <typename TA> __device__ __forceinline__ float ldv(const TA* p, size_t i);
template <> __device__ __forceinline__ float ldv<float>(const float* p, size_t i) { return p[i]; }
template <> __device__ __forceinline__ float ldv<unsigned short>(const unsigned short* p, size_t i) { return __uint_as_float(((unsigned)p[i]) << 16); }
template <typename TA> __global__ void k_cmp(const TA* fast, int fld, int fcol0, const float* orc, int old, int b, int r0, int nr, int nc, int rowmode, float* err) {
    float num = 0.f, den = 0.f;
    const size_t tot = (size_t)nr * nc;
    for (size_t i = (size_t)blockIdx.x * blockDim.x + threadIdx.x; i < tot; i += (size_t)gridDim.x * blockDim.x) {
        const int r = r0 + (int)(i / nc), c = (int)(i % nc);
        const int fr = rowmode == 0 ? fast_row(b, r) : b * T + r;
        const float a = ldv<TA>(fast, (size_t)fr * fld + fcol0 + c), o = orc[(size_t)r * old + c];
        const float d = a - o; num += d * d; den += o * o;
    }
#pragma unroll
    for (int o = 32; o >= 1; o >>= 1) { num += __shfl_xor(num, o); den += __shfl_xor(den, o); }
    if ((threadIdx.x & 63) == 0) { atomicAdd(err, num); atomicAdd(err + 1, den); }
}
__global__ void k_cmp2(const unsigned short* f0, const unsigned short* f1, int fld, const float* orc, int old, int b, int nr, int nc, float* err) {
    float num = 0.f, den = 0.f;
    const size_t tot = (size_t)nr * nc;
    for (size_t i = (size_t)blockIdx.x * blockDim.x + threadIdx.x; i < tot; i += (size_t)gridDim.x * blockDim.x) {
        const int r = (int)(i / nc), c = (int)(i % nc); const size_t fi = (size_t)(b * T + r) * fld + c;
        const float a = ldv<unsigned short>(f0, fi) + ldv<unsigned short>(f1, fi), o = orc[(size_t)r * old + c];
        const float d = a - o; num += d * d; den += o * o;
    }
#pragma unroll
    for (int o = 32; o >= 1; o >>= 1) { num += __shfl_xor(num, o); den += __shfl_xor(den, o); }
    if ((threadIdx.x & 63) == 0) { atomicAdd(err, num); atomicAdd(err + 1, den); }
}
__global__ void k_scale_out(float* out, size_t n, const float* err, int nerr) {
    float e = 0.f; for (int i = 0; i < nerr; ++i) e += sqrtf(err[2 * i] / fmaxf(err[2 * i + 1], 1e-30f));
    if (!(e == e)) e = 10.f;
    if (!(e < 10.f)) e = 10.f;
    for (size_t i = (size_t)blockIdx.x * blockDim.x + threadIdx.x; i < n; i += (size_t)gridDim.x * blockDim.x) out[i] *= (1.f + e);
}
}
namespace pg8 {
#define PG8_LAS __attribute__((address_space(3)))
typedef unsigned short bf16_t;
typedef short bf16x8 __attribute__((ext_vector_type(8)));
typedef float f32x4 __attribute__((ext_vector_type(4)));
typedef unsigned u32x4 __attribute__((ext_vector_type(4)));
constexpr int BM = 256, BK = 64, HALF = 128, HTB = HALF * BK * 2  , STAGE_BYTES = 8 * HTB, NXCD = 8, WGM = 8;

__host__ __device__ __forceinline__ int lds_byte(int r, int c) { const int st = (r >> 4) * 2 + (c >> 5), rr = r & 15, cc = c & 31, ob = rr * 64 + cc * 2; return st * 1024 + (ob ^ (((ob >> 9) & 1) << 5)); }
__host__ __device__ __forceinline__ void stage_rc(int b, int& R, int& C) { const int st = b / 1024, sb = b % 1024, swz = sb ^ (((sb >> 9) & 1) << 5); R = (st >> 1) * 16 + swz / 64; C = (st & 1) * 32 + (swz % 64) / 2; }
__host__ __device__ __forceinline__ int perm32(int rho) { const int n = rho >> 4, i = rho & 15; return 8 * (i >> 2) + 4 * n + (i & 3); }

struct Unit { int pm, pn; };
struct Gemm { const bf16_t* A; const bf16_t* Bt; int M, N, K; };

struct StaticOrder {
    int nM, nN, nwg, G, c;
    __host__ __device__ void init(int M, int N, int G_, int c_) { nM = M / BM; nN = N / BM; nwg = nM * nN; G = G_; c = c_; }
    __host__ __device__ bool next(int i, Unit& u) const {
        const long L = (long)i * G + c; if (L >= nwg) return false;
        int wgid = (int)L; { const int q = nwg / NXCD, r = nwg % NXCD, xcd = wgid % NXCD, off = wgid / NXCD; wgid = (xcd < r ? xcd * (q + 1) : r * (q + 1) + (xcd - r) * q) + off; }
        const int nig = WGM * nN, gid = wgid / nig, fm = gid * WGM, gsz = (nM - fm) < WGM ? (nM - fm) : WGM;
        u.pm = fm + ((wgid % nig) % gsz); u.pn = (wgid % nig) / gsz; return true;
    }
    __device__ __forceinline__ void a_ready(const Unit&) const {}
    __device__ __forceinline__ void done(const Unit&) const {}
};

__device__ __forceinline__ unsigned cvt_pk_bf16(float lo, float hi) { unsigned r; asm volatile("v_cvt_pk_bf16_f32 %0, %1, %2" : "=v"(r) : "v"(lo), "v"(hi)); return r; }
typedef float f32x2 __attribute__((ext_vector_type(2)));
typedef float f32x2 __attribute__((ext_vector_type(2)));
template <class Epi, class Sched, bool ALIGN_EPI = false, bool SP2 = false>
__device__ __forceinline__ void gemm_phase(PG8_LAS unsigned char* lds, const Gemm g, const Sched& S, const Epi& E) {
    const int tid = threadIdx.x, wid = __builtin_amdgcn_readfirstlane(tid >> 6), lane = tid & 63, wr = wid >> 2, wc = wid & 3, fr = lane & 15, fq = lane >> 4;
    const int K = g.K, nt = K / BK;
    unsigned voffA[2], voffB[2];
#pragma unroll
    for (int i = 0; i < 2; ++i) { int R, C; stage_rc(tid * 16 + i * 8192, R, C); const int Rb = Epi::PERM ? ((R & ~31) + perm32(R & 31)) : R;
        voffA[i] = (unsigned)(R * K + C) * 2u; voffB[i] = (unsigned)(Rb * K + C) * 2u; }
    const size_t kstep = (size_t)(BK * 2);
    const size_t hstep = (size_t)HALF * K * 2;
    const size_t tstep = 2 * hstep;
    const unsigned ldsw = (unsigned)wid * 1024u;
    const int aoff = lds_byte(wr * 64 + fr, fq * 8), boff = lds_byte(wc * 32 + fr, fq * 8);
#define PG8_SA(b, h) (((b) * 2 + (h)) * HTB)
#define PG8_SB(b, h) ((4 + (b) * 2 + (h)) * HTB)
#define PG8_STAGE(bufoff, gbase, voff) do { _Pragma("unroll") for (int _i = 0; _i < 2; ++_i) \
        __builtin_amdgcn_global_load_lds((const unsigned*)((const char*)(gbase) + (voff)[_i]), (PG8_LAS unsigned*)(lds + (bufoff) + ldsw + _i * 8192), 16, 0, 0); } while (0)
#define PG8_LDA(dst, b, h) do { _Pragma("unroll") for (int m = 0; m < 4; ++m) _Pragma("unroll") for (int k = 0; k < 2; ++k) dst[m][k] = *(const PG8_LAS bf16x8*)(lds + PG8_SA(b, h) + aoff + m * 2048 + k * 1024); } while (0)
#define PG8_LDB(dst, b, h) do { _Pragma("unroll") for (int n = 0; n < 2; ++n) _Pragma("unroll") for (int k = 0; k < 2; ++k) dst[n][k] = *(const PG8_LAS bf16x8*)(lds + PG8_SB(b, h) + boff + n * 2048 + k * 1024); } while (0)
#define PG8_MMA(ai, bj, At, Bt) do { __builtin_amdgcn_s_setprio(1); _Pragma("unroll") for (int m = 0; m < 4; ++m) _Pragma("unroll") for (int n = 0; n < 2; ++n) _Pragma("unroll") for (int k = 0; k < 2; ++k) \
        acc[ai][bj][m][n] = __builtin_amdgcn_mfma_f32_16x16x32_bf16(Bt[n][k], At[m][k], acc[ai][bj][m][n], 0, 0, 0); __builtin_amdgcn_s_setprio(0); } while (0)
#define PG8_WAIT_V(n) asm volatile("s_waitcnt vmcnt(" #n ")" ::: "memory")
#define PG8_WAIT_L(n) asm volatile("s_waitcnt lgkmcnt(" #n ")" ::: "memory")
#define PG8_BAR __builtin_amdgcn_s_barrier()
#define PG8_SCHED __builtin_amdgcn_sched_barrier(0)
    Unit cur, nxt; int ui = 0;
    if (!S.next(0, cur)) return;
    f32x4 acc[2][2][4][2];
#pragma unroll
    for (int a = 0; a < 2; ++a)
#pragma unroll
        for (int b = 0; b < 2; ++b)
#pragma unroll
            for (int m = 0; m < 4; ++m)
#pragma unroll
                for (int n = 0; n < 2; ++n) acc[a][b][m][n] = (f32x4){0.f, 0.f, 0.f, 0.f};
    bf16x8 At[4][2], B0[2][2], B1[2][2];
    const char* cA = (const char*)g.A + (size_t)cur.pm * tstep; const char* cB = (const char*)g.Bt + (size_t)cur.pn * tstep;
    S.a_ready(cur);
    if constexpr (SP2) {
        PG8_STAGE(PG8_SB(0, 0), cB, voffB); PG8_STAGE(PG8_SB(0, 1), cB + hstep, voffB); PG8_STAGE(PG8_SA(0, 0), cA, voffA); PG8_STAGE(PG8_SA(0, 1), cA + hstep, voffA);
        if (wr == 1) PG8_BAR;
        PG8_WAIT_V(2); PG8_BAR;
        PG8_STAGE(PG8_SB(1, 0), cB + kstep, voffB); PG8_STAGE(PG8_SA(1, 0), cA + kstep, voffA); PG8_STAGE(PG8_SB(1, 1), cB + hstep + kstep, voffB);
        PG8_WAIT_V(6); PG8_BAR;
    } else {
        PG8_STAGE(PG8_SB(0, 0), cB, voffB); PG8_STAGE(PG8_SA(0, 0), cA, voffA); PG8_STAGE(PG8_SB(0, 1), cB + hstep, voffB); PG8_STAGE(PG8_SA(0, 1), cA + hstep, voffA);
        if (wr == 1) PG8_BAR;
        PG8_WAIT_V(4); PG8_BAR;
        PG8_STAGE(PG8_SB(1, 0), cB + kstep, voffB); PG8_STAGE(PG8_SA(1, 0), cA + kstep, voffA); PG8_STAGE(PG8_SB(1, 1), cB + hstep + kstep, voffB);
        PG8_WAIT_V(6); PG8_BAR;
    }
    for (;;) {
        const bool has_next = S.next(ui + 1, nxt);
        const char* nA = has_next ? (const char*)g.A + (size_t)nxt.pm * tstep : cA; const char* nB = has_next ? (const char*)g.Bt + (size_t)nxt.pn * tstep : cB;
        for (int t = 0; t < nt; t += 2) {
            const bool last = (t == nt - 2);
            const char* a1 = cA + (size_t)(t + 1) * kstep;
            const char* a2 = last ? nA : cA + (size_t)(t + 2) * kstep; const char* b2 = last ? nB : cB + (size_t)(t + 2) * kstep;
            const char* a3 = a2 + kstep; const char* b3 = b2 + kstep;
            if (last && has_next) S.a_ready(nxt);
            if constexpr (SP2) {
            PG8_LDB(B0, 0, 0); PG8_LDB(B1, 0, 1); PG8_SCHED; PG8_LDA(At, 0, 0); PG8_STAGE(PG8_SA(1, 1), a1 + hstep, voffA);
            PG8_WAIT_V(8); PG8_WAIT_L(0); PG8_BAR; PG8_MMA(0, 0, At, B0); PG8_MMA(0, 1, At, B1); PG8_BAR; PG8_SCHED;
            PG8_LDA(At, 0, 1); PG8_STAGE(PG8_SB(0, 0), b2, voffB); PG8_STAGE(PG8_SB(0, 1), b2 + hstep, voffB); PG8_STAGE(PG8_SA(0, 0), a2, voffA);
            PG8_WAIT_V(8); PG8_WAIT_L(0); PG8_BAR; PG8_MMA(1, 0, At, B0); PG8_MMA(1, 1, At, B1); PG8_BAR; PG8_SCHED;
            PG8_LDB(B0, 1, 0); PG8_LDB(B1, 1, 1); PG8_SCHED; PG8_LDA(At, 1, 0); PG8_STAGE(PG8_SA(0, 1), a2 + hstep, voffA);
            PG8_WAIT_V(8); PG8_WAIT_L(0); PG8_BAR; PG8_MMA(0, 0, At, B0); PG8_MMA(0, 1, At, B1); PG8_BAR; PG8_SCHED;
            PG8_LDA(At, 1, 1); PG8_STAGE(PG8_SB(1, 0), b3, voffB); PG8_STAGE(PG8_SB(1, 1), b3 + hstep, voffB); PG8_STAGE(PG8_SA(1, 0), a3, voffA);
            PG8_WAIT_V(8); PG8_WAIT_L(0); PG8_BAR; PG8_MMA(1, 0, At, B0); PG8_MMA(1, 1, At, B1); PG8_BAR; PG8_SCHED;
            } else {
            PG8_LDB(B0, 0, 0); PG8_SCHED; PG8_LDA(At, 0, 0); PG8_STAGE(PG8_SA(1, 1), a1 + hstep, voffA);
            PG8_WAIT_L(8); PG8_BAR; PG8_WAIT_L(0); PG8_MMA(0, 0, At, B0); PG8_BAR; PG8_SCHED;
            PG8_LDB(B1, 0, 1); PG8_STAGE(PG8_SB(0, 0), b2, voffB);
            PG8_BAR; PG8_WAIT_L(0); PG8_MMA(0, 1, At, B1); PG8_BAR;
            PG8_LDA(At, 0, 1); PG8_STAGE(PG8_SA(0, 0), a2, voffA);
            PG8_BAR; PG8_WAIT_L(0); PG8_MMA(1, 0, At, B0); PG8_BAR; PG8_SCHED;
            PG8_STAGE(PG8_SB(0, 1), b2 + hstep, voffB);
            PG8_WAIT_V(6); PG8_BAR; PG8_MMA(1, 1, At, B1); PG8_BAR;
            PG8_LDB(B0, 1, 0); PG8_SCHED; PG8_LDA(At, 1, 0); PG8_STAGE(PG8_SA(0, 1), a2 + hstep, voffA);
            PG8_WAIT_L(8); PG8_BAR; PG8_WAIT_L(0); PG8_MMA(0, 0, At, B0); PG8_BAR; PG8_SCHED;
            PG8_LDB(B1, 1, 1); PG8_STAGE(PG8_SB(1, 0), b3, voffB);
            PG8_BAR; PG8_WAIT_L(0); PG8_MMA(0, 1, At, B1); PG8_BAR;
            PG8_LDA(At, 1, 1); PG8_STAGE(PG8_SA(1, 0), a3, voffA);
            PG8_BAR; PG8_WAIT_L(0); PG8_MMA(1, 0, At, B0); PG8_BAR; PG8_SCHED;
            PG8_STAGE(PG8_SB(1, 1), b3 + hstep, voffB);
            PG8_WAIT_V(6); PG8_BAR; PG8_MMA(1, 1, At, B1); PG8_BAR;
            }
        }
        if constexpr (ALIGN_EPI) { if (wr == 0) PG8_BAR; }
        if constexpr (!Epi::AFTER_DRAIN) { E(acc, cur, wr, wc, fr, fq); S.done(cur); }
        if (!has_next) break;
#pragma unroll
        for (int a = 0; a < 2; ++a)
#pragma unroll
            for (int b = 0; b < 2; ++b)
#pragma unroll
                for (int m = 0; m < 4; ++m)
#pragma unroll
                    for (int n = 0; n < 2; ++n) acc[a][b][m][n] = (f32x4){0.f, 0.f, 0.f, 0.f};
        cur = nxt; cA = nA; cB = nB; ++ui;
        if constexpr (ALIGN_EPI) { if (wr == 1) PG8_BAR; }
    }
    PG8_WAIT_V(0);
    if constexpr (!ALIGN_EPI) { if (wr == 0) PG8_BAR; }
    PG8_BAR;
    if constexpr (Epi::AFTER_DRAIN) { E.fused(acc, cur, wr, wc, fr, fq, lds, wid, lane); S.done(cur); }
#undef PG8_SA
#undef PG8_SB
#undef PG8_STAGE
#undef PG8_LDA
#undef PG8_LDB
#undef PG8_MMA
#undef PG8_WAIT_V
#undef PG8_WAIT_L
#undef PG8_BAR
#undef PG8_SCHED
}
}
namespace fk {
#define GAS __attribute__((address_space(1)))
#define LAS __attribute__((address_space(3)))
typedef unsigned short bf16;
typedef unsigned v4u __attribute__((ext_vector_type(4)));
typedef unsigned v2u __attribute__((ext_vector_type(2)));
typedef float f32x4 __attribute__((ext_vector_type(4)));
typedef short bf16x8 __attribute__((ext_vector_type(8)));
typedef GAS unsigned gu32;
#define RLX_AGENT __ATOMIC_RELAXED, __HIP_MEMORY_SCOPE_AGENT
#define LDS_WAIT() asm volatile("s_waitcnt lgkmcnt(0)" ::: "memory")
#define VM_WAIT() asm volatile("s_waitcnt vmcnt(0)" ::: "memory")
__device__ __forceinline__ unsigned f2bf(float f) { unsigned u = __builtin_bit_cast(unsigned, f); return (u + 0x7fffu + ((u >> 16) & 1u)) >> 16; }
__device__ __forceinline__ unsigned pk2(float lo, float hi) { return f2bf(lo) | (f2bf(hi) << 16); }
__device__ __forceinline__ float bf2f(unsigned short b) { return __uint_as_float(((unsigned)b) << 16); }
__device__ __forceinline__ float bflo(unsigned w) { return __uint_as_float(w << 16); }
__device__ __forceinline__ float bfhi(unsigned w) { return __uint_as_float(w & 0xffff0000u); }
__device__ __forceinline__ float sigm(float x) { return 1.f / (1.f + __expf(-x)); }
__device__ __forceinline__ float siluf(float x) { return x / (1.f + __expf(-x)); }
__device__ __forceinline__ float softplusf(float x) { return fmaxf(x, 0.f) + log1pf(__expf(-fabsf(x))); }
__device__ __forceinline__ float wave_sum(float v) {
#pragma unroll
    for (int o = 1; o < 64; o <<= 1) v += __shfl_xor(v, o);
    return v;
}
#define XB_TMO      128
#define XB_XCNT(j)  (256  + 64 * (j))
#define XB_XSUB(j)  (1280 + 64 * (j))
#define XB_XGEN(j)  (2304 + 64 * (j))
#define XB_TOP      3328
#define XB_TOPGEN   3392
#define XCD_BAR_WORDS 3456
#define XB_SPIN_CAP (1u << 18)

__device__ __forceinline__ unsigned xb_ld(unsigned* p)              { return __hip_atomic_load(p, __ATOMIC_RELAXED, __HIP_MEMORY_SCOPE_AGENT); }
__device__ __forceinline__ unsigned xb_add(unsigned* p, unsigned v) { return __hip_atomic_fetch_add(p, v, __ATOMIC_RELAXED, __HIP_MEMORY_SCOPE_AGENT); }
__device__ __forceinline__ unsigned xb_xcc_id() { return (unsigned)__builtin_amdgcn_s_getreg((3 << 11) | 20) & 0xFu; }
#define XB_SPIN(cond, bar) do { unsigned _sp = 0; while (cond) { __builtin_amdgcn_s_sleep(1); \
    if ((++_sp & 255u) == 0u) { if (xb_ld(&(bar)[XB_TMO])) break; if (_sp > XB_SPIN_CAP) { atomicAdd(&(bar)[XB_TMO], 1u); break; } } } } while (0)

struct XcdBarrier {
    unsigned* bar; unsigned x;
    volatile LAS unsigned* st;
};

__device__ __forceinline__ XcdBarrier xcd_barrier_post(unsigned* bar, volatile LAS unsigned* st) {
    XcdBarrier b; b.bar = bar; b.x = xb_xcc_id(); b.st = st;
    if (threadIdx.x == 0) (void)xb_add(&bar[XB_XCNT(b.x)], 1u);
    return b;
}
__device__ __forceinline__ void xcd_barrier_complete(unsigned* bar, unsigned x, unsigned& nloc, unsigned& nx) {
    const unsigned G = gridDim.x * gridDim.y * gridDim.z;
    unsigned sum, cnt, mine, sp = 0u;
    for (;;) {
        sum = 0u; cnt = 0u; mine = 0u;
#pragma unroll
        for (unsigned j = 0; j < 16; ++j) { const unsigned c = xb_ld(&bar[XB_XCNT(j)]); sum += c; cnt += (c > 0u) ? 1u : 0u; mine = (j == x) ? c : mine; }
        if (sum == G) break;
        __builtin_amdgcn_s_sleep(1);
        if ((++sp & 255u) == 0u) { if (xb_ld(&bar[XB_TMO])) break; if (sp > XB_SPIN_CAP) { atomicAdd(&bar[XB_TMO], 1u); break; } }
    }
    nloc = mine > 0u ? mine : 1u; nx = cnt > 0u ? cnt : 1u;
}

__device__ __forceinline__ void xcd_barrier(const XcdBarrier& b) {
    asm volatile("s_waitcnt vmcnt(0)" ::: "memory");
    __syncthreads();
    if (threadIdx.x == 0) {
        unsigned* bar = b.bar;
        __builtin_amdgcn_s_waitcnt(0);
        unsigned nloc = b.st[0], nx = b.st[1];
        if (nloc == 0u) { xcd_barrier_complete(bar, b.x, nloc, nx); b.st[0] = nloc; b.st[1] = nx; }
        const unsigned old = xb_add(&bar[XB_XSUB(b.x)], 1u);
        const unsigned gen = old / nloc;
        if (old + 1u == (gen + 1u) * nloc) {
            __builtin_amdgcn_fence(__ATOMIC_RELEASE, "agent");
            asm volatile("s_waitcnt vmcnt(0)" ::: "memory");
            const unsigned og = xb_add(&bar[XB_TOP], 1u);
            const unsigned tg = og / nx;
            if (og + 1u == (tg + 1u) * nx) xb_add(&bar[XB_TOPGEN], 1u);
            else XB_SPIN(xb_ld(&bar[XB_TOPGEN]) == tg, bar);
            __builtin_amdgcn_fence(__ATOMIC_ACQUIRE, "agent");
            xb_add(&bar[XB_XGEN(b.x)], 1u);
            asm volatile("s_waitcnt vmcnt(0)" ::: "memory");
        } else {
            XB_SPIN(xb_ld(&bar[XB_XGEN(b.x)]) == gen, bar);
            __builtin_amdgcn_fence(__ATOMIC_ACQUIRE, "agent");
            asm volatile("s_waitcnt vmcnt(0)" ::: "memory");
        }
    }
    __syncthreads();
}
constexpr int NWAVES = 8, NTHR = 512;
constexpr int D = 1024, T = 4096, CT = 256, NB = 4, NH = 8, DK = 128, FF = 4096, INT = 11296;
constexpr int ML = NB * T, MC = NB * CT, MR = ML + MC;
constexpr int NCH = 68;
constexpr float EPS = 1e-6f;
constexpr int NW1 = 11520, R_QKV = 0, R_AB = 3072, R_G2 = 3328, R_GA = 7424, R_GB = 8448, R_MG = 9472;
constexpr int N_G1 = 3328, N_G2 = 4096, N_G3 = 4096;
constexpr size_t MiB = 1u << 20;
constexpr size_t WS_CTL = 0, CTL_ZERO_BYTES = 1 * MiB;
constexpr size_t WS_MOD = 1 * MiB, WS_LB = WS_MOD + 128 * 1024;
constexpr size_t WS_LA = 1 * MiB + 512 * 1024, WS_BE = 2 * MiB + 768 * 1024;
constexpr size_t WS_ZQ = 4 * MiB;
constexpr size_t WS_QKVC = 106 * MiB;
constexpr size_t WS_TM = 208 * MiB;
constexpr size_t WS_WSM = 242 * MiB;
constexpr size_t WS_END = 256 * MiB;
constexpr size_t DO_H = 0;
constexpr size_t DO_WIN = 34 * MiB;
constexpr size_t DO_GB = 57 * MiB;
constexpr int CW_TMO = 0, CW_BAR = 4096, CW_ERR = 16384;
constexpr int LDS_BYTES = 147456, MISC_OFF = LDS_BYTES - 256;

struct Args { const float* in[19]; float* out; unsigned char* ws; int ph_lo, ph_hi, li, pad; };
static_assert(sizeof(Args) == 19 * 8 + 8 + 8 + 16, "Args has no padding");

struct Frame {
    LAS unsigned char* lds; volatile LAS unsigned* MISC; gu32* ctl;
    int tid, lane, wave, vcu, G;
    const float *x, *c, *ctx, *c_ctx, *w_ada, *b_ada, *norm_g, *w_in, *conv_w, *a_log, *dt_bias, *gdn_nw, *lb_logits, *hgrn_nw, *w_ba, *w_bb, *w_out, *w1, *w2;
    float* out; unsigned char* ws; unsigned char* dob;
};

__device__ __forceinline__ void p0_transpose_item(const float* W, int ldw, int k0, int c0, bf16* WT, int ldt, int r0, LAS float* scr, int lane) {
#pragma unroll 8
    for (int i = 0; i < 32; ++i) { const int kk = 2 * i + (lane >> 5); scr[kk * 33 + (lane & 31)] = W[(size_t)(k0 + kk) * ldw + c0 + (lane & 31)]; }
    LDS_WAIT(); asm volatile("" ::: "memory");
    const int c = lane & 7;
#pragma unroll
    for (int j = 0; j < 4; ++j) { const int n = (lane >> 3) + 8 * j; const LAS float* s = scr + (8 * c) * 33 + n;
        v4u o; o.x = pk2(s[0 * 33], s[1 * 33]); o.y = pk2(s[2 * 33], s[3 * 33]); o.z = pk2(s[4 * 33], s[5 * 33]); o.w = pk2(s[6 * 33], s[7 * 33]);
        *(GAS v4u*)(WT + (size_t)(r0 + n) * ldt + k0 + 8 * c) = o; }
    LDS_WAIT(); asm volatile("" ::: "memory");
}
__device__ __forceinline__ void p0_prologue(Frame& F) {
    LAS float* scr = (LAS float*)(F.lds + F.wave * 8704);
    const int gw = F.vcu * NWAVES + F.wave, NGW = F.G * NWAVES;
    bf16* WinT = (bf16*)(F.dob + DO_WIN); bf16* WaT = (bf16*)(F.ws + WS_WSM); bf16* WbT = WaT + (size_t)D * D; bf16* WoT = WbT + (size_t)D * D; bf16* W1T = WoT + (size_t)D * D;
    if (F.vcu < 192) {
        LAS float* sil = (LAS float*)(F.lds + 8 * 8704);
        LAS float* part = (LAS float*)(F.lds + 8 * 8704 + 20480);
        for (int i = F.tid; i < 5 * D; i += NTHR) { const int r = i >> 10, k = i & 1023; sil[i] = siluf(r < 4 ? F.c[r * D + k] : F.c_ctx[k]); }
        __syncthreads();
        for (int cb = F.vcu; cb < 192; cb += F.G) {
            const int n = cb * 32 + (F.lane & 31), kh = F.lane >> 5;
            float a0 = 0.f, a1 = 0.f, a2 = 0.f, a3 = 0.f, a4 = 0.f;
#pragma unroll 16
            for (int i = 0; i < 64; ++i) { const int k = F.wave * 128 + 2 * i + kh; const float w = F.w_ada[(size_t)k * 6 * D + n];
                a0 += sil[k] * w; a1 += sil[D + k] * w; a2 += sil[2 * D + k] * w; a3 += sil[3 * D + k] * w; a4 += sil[4 * D + k] * w; }
            a0 += __shfl_xor(a0, 32); a1 += __shfl_xor(a1, 32); a2 += __shfl_xor(a2, 32); a3 += __shfl_xor(a3, 32); a4 += __shfl_xor(a4, 32);
            if (F.lane < 32) { part[(F.wave * 5 + 0) * 32 + F.lane] = a0; part[(F.wave * 5 + 1) * 32 + F.lane] = a1; part[(F.wave * 5 + 2) * 32 + F.lane] = a2; part[(F.wave * 5 + 3) * 32 + F.lane] = a3; part[(F.wave * 5 + 4) * 32 + F.lane] = a4; }
            __syncthreads();
            if (F.tid < 160) { const int r = F.tid >> 5, cc = F.tid & 31; float s = 0.f;
#pragma unroll
                for (int w = 0; w < 8; ++w) s += part[(w * 5 + r) * 32 + cc];
                const int col = cb * 32 + cc; ((float*)(F.ws + WS_MOD))[r * 6 * D + col] = s + F.b_ada[col]; }
            __syncthreads();
        }
    }
    if (F.vcu == F.G - 1) {
        float* lb = (float*)(F.ws + WS_LB);
        for (int i = F.tid; i < 2 * D; i += NTHR) { const float l0 = F.lb_logits[i], l1 = F.lb_logits[2 * D + i], m = fmaxf(l0, l1), e0 = __expf(l0 - m), e1 = __expf(l1 - m); lb[i] = e0 / (e0 + e1); }
    }
    { v4u z = {0u, 0u, 0u, 0u}; GAS v4u* p = (GAS v4u*)(WinT + (size_t)(R_AB + 32) * D); const int n16 = 224 * D * 2 / 16;
      for (int i = F.vcu * NTHR + F.tid; i < n16; i += F.G * NTHR) p[i] = z; }
    constexpr int NITEMS = 16 * (96 + 1 + 128 + 32 + 32 + 64 + 32 + 32 + 32 + 128);
    for (int it = gw; it < NITEMS; it += NGW) {
        int r = it;
#define TRSEG(W_, ldw_, K_, c0_, ncols_, WT_, ldt_, r0_) { const int nblk_ = (ncols_) / 32, n_ = ((K_) / 64) * nblk_; \
            if (r < n_) { const int kb_ = r / nblk_, nb_ = r % nblk_; p0_transpose_item(W_, ldw_, 64 * kb_, (c0_) + 32 * nb_, WT_, ldt_, (r0_) + 32 * nb_, scr, F.lane); continue; } r -= n_; }
        TRSEG(F.w_in, INT, D, 0, 3072, WinT, D, R_QKV)
        TRSEG(F.w_in, INT, D, 4096, 32, WinT, D, R_AB)
        TRSEG(F.w_in, INT, D, 4128, 4096, WinT, D, R_G2)
        TRSEG(F.w_in, INT, D, 3072, 1024, WinT, D, R_GA)
        TRSEG(F.w_in, INT, D, 8224, 1024, WinT, D, R_GB)
        TRSEG(F.w_in, INT, D, 9248, 2048, WinT, D, R_MG)
        TRSEG(F.w_ba, D, D, 0, D, WaT, D, 0)
        TRSEG(F.w_bb, D, D, 0, D, WbT, D, 0)
        TRSEG(F.w_out, D, D, 0, D, WoT, D, 0)
        TRSEG(F.w1, FF, D, 0, FF, W1T, D, 0)
#undef TRSEG
    }
}
__device__ __forceinline__ void p1_hrows(Frame& F) {
    const int gw = F.vcu * NWAVES + F.wave, NGW = F.G * NWAVES;
    bf16* H = (bf16*)(F.dob + DO_H); const float* mod = (const float*)(F.ws + WS_MOD);
    for (int m = gw; m < MR; m += NGW) {
        const float* xr = m < ML ? F.x + (size_t)m * D : F.ctx + (size_t)(m - ML) * D;
        const float* mr = mod + (size_t)(m < ML ? (m >> 12) : 4) * 6 * D;
        const GAS f32x4* xp = (const GAS f32x4*)xr + F.lane;
        f32x4 v[4]; float s = 0.f;
#pragma unroll
        for (int j = 0; j < 4; ++j) { v[j] = xp[64 * j]; s += (v[j].x * v[j].x + v[j].y * v[j].y) + (v[j].z * v[j].z + v[j].w * v[j].w); }
        const float inv = 1.0f / sqrtf(wave_sum(s) * (1.f / D) + EPS);
        GAS v2u* o8 = (GAS v2u*)(H + (size_t)m * D) + F.lane;
#pragma unroll
        for (int j = 0; j < 4; ++j) { const int col = 4 * F.lane + 256 * j;
            const f32x4 g = *(const f32x4*)(F.norm_g + col), sh = *(const f32x4*)(mr + col), sc = *(const f32x4*)(mr + D + col);
            const f32x4 h = (v[j] * inv * g) * (sc + 1.0f) + sh;
            v2u o; o.x = pk2(h.x, h.y); o.y = pk2(h.z, h.w); o8[64 * j] = o; }
    }
}
struct EpiG1 {
    static constexpr bool PERM = true, AFTER_DRAIN = false;
    bf16* Zq; float* la; float* be; const float* a_log; const float* dt_bias;
    __device__ __forceinline__ void operator()(const pg8::f32x4 (&acc)[2][2][4][2], const pg8::Unit& u, int wr, int wc, int fr, int fq) const {
        const int row0 = u.pm * 256 + wr * 64 + fr;
        if (u.pn < 12) {
            const int col0 = u.pn * 256 + wc * 32 + 8 * fq;
#pragma unroll
            for (int ai = 0; ai < 2; ++ai)
#pragma unroll
                for (int m = 0; m < 4; ++m) { bf16* rowp = Zq + (size_t)(row0 + ai * 128 + m * 16) * 3072 + col0;
#pragma unroll
                    for (int bj = 0; bj < 2; ++bj) { const pg8::f32x4 v0 = acc[ai][bj][m][0], v1 = acc[ai][bj][m][1];
                        pg8::u32x4 w; w.x = pg8::cvt_pk_bf16(v0[0], v0[1]); w.y = pg8::cvt_pk_bf16(v0[2], v0[3]); w.z = pg8::cvt_pk_bf16(v1[0], v1[1]); w.w = pg8::cvt_pk_bf16(v1[2], v1[3]);
                        *(pg8::u32x4*)(rowp + bj * 128) = w; } }
        } else if (wc == 0) {
#pragma unroll
            for (int n = 0; n < 2; ++n) { const int c0 = 8 * fq + 4 * n;
                if (c0 < 16) { const f32x4 al = *(const f32x4*)(a_log + c0), dt = *(const f32x4*)(dt_bias + c0);
#pragma unroll
                    for (int ai = 0; ai < 2; ++ai)
#pragma unroll
                        for (int m = 0; m < 4; ++m) { const pg8::f32x4 v = acc[ai][0][m][n]; f32x4 o;
                            o.x = -__expf(al.x) * softplusf(v[0] + dt.x); o.y = -__expf(al.y) * softplusf(v[1] + dt.y); o.z = -__expf(al.z) * softplusf(v[2] + dt.z); o.w = -__expf(al.w) * softplusf(v[3] + dt.w);
                            *(f32x4*)(la + (size_t)(row0 + ai * 128 + m * 16) * 16 + c0) = o; }
                } else {
#pragma unroll
                    for (int ai = 0; ai < 2; ++ai)
#pragma unroll
                        for (int m = 0; m < 4; ++m) { const pg8::f32x4 v = acc[ai][0][m][n]; f32x4 o; o.x = sigm(v[0]); o.y = sigm(v[1]); o.z = sigm(v[2]); o.w = sigm(v[3]);
                            *(f32x4*)(be + (size_t)(row0 + ai * 128 + m * 16) * 16 + (c0 - 16)) = o; }
                } }
        }
    }
};
namespace prep {
constexpr int ST = 0, KS = 50688, AC = 67072, GBL = 132608;
constexpr int NUNITS = NB * NCH * 2;
}
__device__ __forceinline__ int chunk_tok0(int b, int n) { return n < 4 ? ML + b * CT + 64 * n : b * T + 64 * (n - 4); }

__device__ __forceinline__ void tri_solve_lower(const LAS float* Ab, int c, float (&X)[64]) {
    int z0 = 0, z1 = 0;
#pragma unroll
    for (int i = 0; i < 64; ++i) {
        const LAS float* row = Ab + i * 64 + z0;
        float s0 = (i == c) ? 1.f : 0.f, s1 = 0.f, s2 = 0.f, s3 = 0.f;
#pragma unroll
        for (int jj = 0; jj < (i + 3) / 4; ++jj) {
            const f32x4 a = *(const LAS f32x4*)(row + 4 * jj);
            if (4 * jj + 0 < i) s0 -= a.x * X[4 * jj + 0];
            if (4 * jj + 1 < i) s1 -= a.y * X[4 * jj + 1];
            if (4 * jj + 2 < i) s2 -= a.z * X[4 * jj + 2];
            if (4 * jj + 3 < i) s3 -= a.w * X[4 * jj + 3];
        }
        X[i] = (s0 + s1) + (s2 + s3);
        z0 = z1; int t = 0; asm volatile("" : "+v"(t), "+v"(X[i])); z1 = t;
    }
}
__device__ __forceinline__ void tri_solve_upper(const LAS float* Ab, int c, float (&X)[64]) {
    int z0 = 0, z1 = 0;
#pragma unroll
    for (int i = 63; i >= 0; --i) {
        const LAS float* row = Ab + i * 64 + z0;
        float s0 = (i == c) ? 1.f : 0.f, s1 = 0.f, s2 = 0.f, s3 = 0.f;
#pragma unroll
        for (int jj = (i + 1) / 4; jj < 16; ++jj) {
            const f32x4 a = *(const LAS f32x4*)(row + 4 * jj);
            if (4 * jj + 0 > i) s0 -= a.x * X[4 * jj + 0];
            if (4 * jj + 1 > i) s1 -= a.y * X[4 * jj + 1];
            if (4 * jj + 2 > i) s2 -= a.z * X[4 * jj + 2];
            if (4 * jj + 3 > i) s3 -= a.w * X[4 * jj + 3];
        }
        X[i] = (s0 + s1) + (s2 + s3);
        z0 = z1; int t = 0; asm volatile("" : "+v"(t), "+v"(X[i])); z1 = t;
    }
}

__device__ __forceinline__ void p3_gdn_prep(Frame& F) {
    using namespace prep;
    const bf16* Zq = (const bf16*)(F.ws + WS_ZQ); bf16* QKVc = (bf16*)(F.ws + WS_QKVC); bf16* TM = (bf16*)(F.ws + WS_TM); float* GB = (float*)(F.dob + DO_GB);
    const float* la = (const float*)(F.ws + WS_LA); const float* be = (const float*)(F.ws + WS_BE);
    LAS unsigned char* st = F.lds + ST; LAS unsigned char* ks = F.lds + KS; LAS float* ac = (LAS float*)(F.lds + AC); LAS float* gbl = (LAS float*)(F.lds + GBL);
    const int wave = F.wave;
    for (int unit = F.vcu; unit < NUNITS; unit += F.G) {
        int tid = F.tid; asm volatile("" : "+v"(tid));
        const int lane = tid & 63;
        const int hg = unit & 1, n = (unit >> 1) % NCH, b = (unit >> 1) / NCH;
        const bool isctx = n < 4; const int r = n - 4;
        const int tok0 = chunk_tok0(b, n);
        __syncthreads();
        { const int hl = wave >> 1, dir = wave & 1, h = hg * 4 + hl;
          float g = la[(size_t)(tok0 + lane) * 16 + dir * 8 + h]; const float bt = be[(size_t)(tok0 + lane) * 16 + dir * 8 + h];
          if (dir == 0) {
#pragma unroll
              for (int o = 1; o < 64; o <<= 1) { const float t = __shfl_up(g, o); if (lane >= o) g += t; }
          } else {
#pragma unroll
              for (int o = 1; o < 64; o <<= 1) { const float t = __shfl_down(g, o); if (lane + o < 64) g += t; }
          }
          gbl[((hl * 2 + dir) * 2 + 0) * 64 + lane] = g; gbl[((hl * 2 + dir) * 2 + 1) * 64 + lane] = bt;
          float* gb = GB + ((size_t)((b * NCH + n) * NH + h) * 2 + dir) * 128; const int id = dir == 0 ? lane : 63 - lane;
          gb[id] = g; gb[64 + id] = bt; }
        v4u pre[6]; v4u prehalo;
#define P3_ISSUE(part_) do { const int hl_ = (part_) / 3, p_ = (part_) % 3, cb_ = p_ * 1024 + (hg * 4 + hl_) * 128; \
            _Pragma("unroll") for (int k = 0; k < 6; ++k) { const int q = tid + 512 * k, dy = q >> 10, c = (q >> 4) & 63, k16 = q & 15; \
                bool ok; int tok; \
                if (isctx) { ok = dy == 1; tok = tok0 + c; } else { const int rr = r + dy - 1; ok = rr >= 0 && rr < 64; tok = b * T + rr * 64 + c; } \
                pre[k] = ok ? *(const GAS v4u*)(Zq + (size_t)tok * 3072 + cb_ + k16 * 8) : (v4u){0u, 0u, 0u, 0u}; } \
            prehalo = (v4u){0u, 0u, 0u, 0u}; \
            if (isctx && (tid >> 5) == 1) { const int side = (tid >> 4) & 1, k16 = tid & 15, t = side == 0 ? 64 * n - 1 : 64 * n + 64; \
                if (t >= 0 && t < CT) prehalo = *(const GAS v4u*)(Zq + (size_t)(ML + b * CT + t) * 3072 + cb_ + k16 * 8); } } while (0)
        P3_ISSUE(0);
        for (int part = 0; part < 12; ++part) {
            const int hl = part / 3, p = part % 3, h = hg * 4 + hl, cb = p * 1024 + h * 128;
            __syncthreads();
#pragma unroll
            for (int k = 0; k < 6; ++k) { const int q = tid + 512 * k, dy = q >> 10, c = (q >> 4) & 63, k16 = q & 15;
                *(LAS v4u*)(st + ((dy * 66 + c + 1) * 256 + k16 * 16)) = pre[k]; }
            if (tid < 96) { const int dy = tid >> 5, side = (tid >> 4) & 1, k16 = tid & 15;
                *(LAS v4u*)(st + ((dy * 66 + side * 65) * 256 + k16 * 16)) = (dy == 1) ? prehalo : (v4u){0u, 0u, 0u, 0u}; }
            __syncthreads();
            if (part + 1 < 12) P3_ISSUE(part + 1);
            { const int ch4 = tid & 31, tg = tid >> 5, c0 = 4 * tg;
              float y[4][4];
#pragma unroll
              for (int j = 0; j < 4; ++j)
#pragma unroll
                  for (int e = 0; e < 4; ++e) y[j][e] = 0.f;
#pragma unroll
              for (int dy = 0; dy < 3; ++dy) {
                  float in[6][4];
#pragma unroll
                  for (int x = 0; x < 6; ++x) { const v2u w = *(const LAS v2u*)(st + ((dy * 66 + c0 + x) * 256 + ch4 * 8)); in[x][0] = bflo(w.x); in[x][1] = bfhi(w.x); in[x][2] = bflo(w.y); in[x][3] = bfhi(w.y); }
#pragma unroll
                  for (int dx = 0; dx < 3; ++dx) { const f32x4 w = *(const f32x4*)(F.conv_w + (size_t)(dy * 3 + dx) * 3072 + cb + 4 * ch4);
#pragma unroll
                      for (int j = 0; j < 4; ++j) { y[j][0] += w.x * in[j + dx][0]; y[j][1] += w.y * in[j + dx][1]; y[j][2] += w.z * in[j + dx][2]; y[j][3] += w.w * in[j + dx][3]; } }
              }
#pragma unroll
              for (int j = 0; j < 4; ++j) {
#pragma unroll
                  for (int e = 0; e < 4; ++e) y[j][e] = siluf(y[j][e]);
                  float sc = 1.f;
                  if (p < 2) { float s = (y[j][0] * y[j][0] + y[j][1] * y[j][1]) + (y[j][2] * y[j][2] + y[j][3] * y[j][3]);
#pragma unroll
                      for (int o = 1; o < 32; o <<= 1) s += __shfl_xor(s, o);
                      sc = (1.0f / sqrtf(s + EPS)) * (p == 0 ? 0.08838834764831845f : 1.0f); }
                  v2u o; o.x = pk2(y[j][0] * sc, y[j][1] * sc); o.y = pk2(y[j][2] * sc, y[j][3] * sc);
                  const int row = c0 + j;
                  *(GAS v2u*)(QKVc + (size_t)(tok0 + row) * 3072 + cb + 4 * ch4) = o;
                  if (p == 1) *(LAS v2u*)(ks + row * 256 + ((((ch4 >> 1) ^ (row & 7)) << 4) | ((ch4 & 1) << 3))) = o;
              } }
            if (p == 1) {
                __syncthreads();
                const int fr = lane & 15, fq = lane >> 4;
                LAS float* A = ac + hl * 4096;
                const LAS float* g0 = gbl + ((hl * 2 + 0) * 2 + 0) * 64; const LAS float* b0 = g0 + 64; const LAS float* g1 = gbl + ((hl * 2 + 1) * 2 + 0) * 64; const LAS float* b1 = g1 + 64;
#pragma unroll
                for (int tt = 0; tt < 2; ++tt) { const int t = 2 * wave + tt, ti = t >> 2, tj = t & 3;
                    pg8::f32x4 acc = {0.f, 0.f, 0.f, 0.f};
#pragma unroll
                    for (int kk = 0; kk < 4; ++kk) { const int ra = 16 * ti + fr, rb = 16 * tj + fr, ch = kk * 4 + fq;
                        const bf16x8 fa = *(const LAS bf16x8*)(ks + ra * 256 + ((ch ^ (ra & 7)) << 4)); const bf16x8 fb = *(const LAS bf16x8*)(ks + rb * 256 + ((ch ^ (rb & 7)) << 4));
                        acc = __builtin_amdgcn_mfma_f32_16x16x32_bf16(fa, fb, acc, 0, 0, 0); }
                    const int j = 16 * tj + fr;
#pragma unroll
                    for (int e = 0; e < 4; ++e) { const int i = 16 * ti + 4 * fq + e; float v = 0.f;
                        if (j < i) v = b0[i] * acc[e] * __expf(g0[i] - g0[j]);
                        else if (j > i) v = b1[i] * acc[e] * __expf(g1[i] - g1[j]);
                        A[i * 64 + j] = v; } }
            }
        }
        __syncthreads();
        { const int hl = wave >> 1, dir = wave & 1, h = hg * 4 + hl;
          const LAS float* A = ac + hl * 4096; float X[64]; int cl = lane; asm volatile("" : "+v"(cl));
          bf16* tm = TM + ((size_t)((b * NCH + n) * NH + h) * 2 + dir) * 4096;
          if (dir == 0) { tri_solve_lower(A, cl, X);
#pragma unroll
              for (int i = 0; i < 64; ++i) tm[i * 64 + lane] = (bf16)f2bf(X[i]);
          } else { tri_solve_upper(A, cl, X);
#pragma unroll
              for (int i = 0; i < 64; ++i) tm[(63 - i) * 64 + (63 - lane)] = (bf16)f2bf(X[i]);
          } }
    }
#undef P3_ISSUE
}
__device__ __forceinline__ unsigned off_b(unsigned row, unsigned ch) { return 256u * row + 16u * (ch ^ (((row & 3) << 2) | ((row >> 2) & 3))); }
__device__ __forceinline__ unsigned off64(unsigned row, unsigned ch) { return 128u * row + 16u * (ch ^ ((row >> 1) & 7)); }
__device__ __forceinline__ unsigned off_v(unsigned row, unsigned ch) { return 64u * row + 16u * (ch ^ ((row >> 1) & 3)); }
__device__ __forceinline__ unsigned tr_addr_b(unsigned lane, unsigned c, unsigned ks, unsigned t) { const unsigned g = lane >> 4, q = (lane & 15) >> 2, p = lane & 3; return off_b(32 * ks + 8 * g + 4 * t + q, 2 * c + (p >> 1)) + 8 * (p & 1); }
__device__ __forceinline__ unsigned tr_addr_v(unsigned lane, unsigned c, unsigned ks, unsigned t) { const unsigned g = lane >> 4, q = (lane & 15) >> 2, p = lane & 3; return off_v(32 * ks + 8 * g + 4 * t + q, 2 * c + (p >> 1)) + 8 * (p & 1); }
__device__ __forceinline__ bf16x8 tr_frag(unsigned a0, unsigned a1) {
    v2u r0, r1;
    asm volatile("ds_read_b64_tr_b16 %0, %2\n\tds_read_b64_tr_b16 %1, %3\n\ts_waitcnt lgkmcnt(0)" : "=&v"(r0), "=&v"(r1) : "v"(a0), "v"(a1) : "memory");
    v4u w; w.x = r0.x; w.y = r0.y; w.z = r1.x; w.w = r1.y; return __builtin_bit_cast(bf16x8, w);
}
namespace gscan {
constexpr int QS = 0, KSI = 16384, TP = 32768, TPP = 40960, VS = 49152, ATT = 53248, NW = 61440, STI = 77824, VN1 = 86016, VN2 = 90112, GF = 94208;
constexpr int NV = 32, NITEMS = NB * NH * 2 * 4;
}
constexpr size_t WS_OAF = 4 * MiB, WS_OAB = 36 * MiB;

__device__ __forceinline__ void p4_gdn_scan(Frame& F) {
    using namespace gscan;
    const bf16* QKVc = (const bf16*)(F.ws + WS_QKVC); const bf16* TM = (const bf16*)(F.ws + WS_TM); const float* GB = (const float*)(F.dob + DO_GB);
    LAS unsigned char* L = F.lds; const unsigned LB = (unsigned)(unsigned long long)F.lds;
    LAS float* eg = (LAS float*)(L + GF); LAS float* dg = eg + 64; LAS float* gs = eg + 128;
    const int wave = F.wave;
    for (int item = F.vcu; item < NITEMS; item += F.G) {
        int tid = F.tid; asm volatile("" : "+v"(tid));
        const int lane = tid & 63, fr = lane & 15, fq = lane >> 4;
        const int vs = item & 3, dir = (item >> 2) & 1, h = (item >> 3) & 7, b = item >> 6;
        bf16* Oout = (bf16*)(F.ws + (dir == 0 ? WS_OAF : WS_OAB));
        pg8::f32x4 Sacc[2] = {{0.f, 0.f, 0.f, 0.f}, {0.f, 0.f, 0.f, 0.f}};
        __syncthreads();
        for (int i = tid; i < 8192 / 4; i += NTHR) ((LAS unsigned*)(L + STI))[i] = 0u;
        v4u pq[2], pk[2], pv, pt; f32x4 pg0, pg1, pb0, pb1; float pgl, pgi;
#define P4_ISSUE(s_) do { const int nm_ = dir == 0 ? (s_) : ((s_) < 4 ? 3 - (s_) : 67 - ((s_) - 4)); const int tk0_ = chunk_tok0(b, nm_); \
        _Pragma("unroll") for (int k = 0; k < 2; ++k) { const int q = tid + 512 * k, i = q >> 4, ch = q & 15; const size_t ro = (size_t)(tk0_ + (dir == 0 ? i : 63 - i)) * 3072 + h * 128 + ch * 8; \
            pq[k] = *(const GAS v4u*)(QKVc + ro); pk[k] = *(const GAS v4u*)(QKVc + ro + 1024); } \
        if (tid < 256) { const int j = tid >> 2, ch = tid & 3; pv = *(const GAS v4u*)(QKVc + (size_t)(tk0_ + (dir == 0 ? j : 63 - j)) * 3072 + 2048 + h * 128 + NV * vs + ch * 8); } \
        const size_t ci_ = ((size_t)((b * NCH + nm_) * NH + h) * 2 + dir); \
        pt = *(const GAS v4u*)(TM + ci_ * 4096 + (tid >> 3) * 64 + (tid & 7) * 8); \
        const float* gb_ = GB + ci_ * 128; pg0 = *(const f32x4*)(gb_ + (tid & 7) * 8); pg1 = *(const f32x4*)(gb_ + (tid & 7) * 8 + 4); pb0 = *(const f32x4*)(gb_ + 64 + (tid & 7) * 8); pb1 = *(const f32x4*)(gb_ + 64 + (tid & 7) * 8 + 4); \
        pgl = gb_[63]; pgi = gb_[lane]; } while (0)
        P4_ISSUE(0);
        for (int s = 0; s < NCH; ++s) {
            const int nm = dir == 0 ? s : (s < 4 ? 3 - s : 67 - (s - 4)); const int tok0 = chunk_tok0(b, nm);
#pragma unroll
            for (int k = 0; k < 2; ++k) { const int q = tid + 512 * k, i = q >> 4, ch = q & 15; *(LAS v4u*)(L + QS + off_b(i, ch)) = pq[k]; *(LAS v4u*)(L + KSI + off_b(i, ch)) = pk[k]; }
            if (tid < 256) { const int j = tid >> 2, ch = tid & 3; *(LAS v4u*)(L + VS + off_v(j, ch)) = pv; }
            { const int i = tid >> 3, ch = tid & 7; const float glast = pgl;
              const float sg[8] = {pg0.x, pg0.y, pg0.z, pg0.w, pg1.x, pg1.y, pg1.z, pg1.w}, sb[8] = {pb0.x, pb0.y, pb0.z, pb0.w, pb1.x, pb1.y, pb1.z, pb1.w};
              const unsigned tw[4] = {pt.x, pt.y, pt.z, pt.w}; unsigned o1[4], o2[4];
#pragma unroll
              for (int e = 0; e < 4; ++e) { const float t0 = bflo(tw[e]), t1 = bfhi(tw[e]);
                  o1[e] = pk2(t0 * sb[2 * e] * __expf(sg[2 * e]), t1 * sb[2 * e + 1] * __expf(sg[2 * e + 1])); o2[e] = pk2(t0 * sb[2 * e], t1 * sb[2 * e + 1]); }
              *(LAS v4u*)(L + TP + off64(i, ch)) = (v4u){o1[0], o1[1], o1[2], o1[3]}; *(LAS v4u*)(L + TPP + off64(i, ch)) = (v4u){o2[0], o2[1], o2[2], o2[3]};
              if (tid < 64) { eg[tid] = __expf(pgi); dg[tid] = __expf(glast - pgi); gs[tid] = pgi; } }
            const float dlast = __expf(pgl);
            __syncthreads();
            if (s + 1 < NCH) P4_ISSUE(s + 1);
#pragma unroll
            for (int tt = 0; tt < 2; ++tt) { const int t = 2 * wave + tt, tj = t >> 2, ti = t & 3;
                pg8::f32x4 acc = {0.f, 0.f, 0.f, 0.f};
                if (tj <= ti) {
#pragma unroll
                    for (int ks = 0; ks < 4; ++ks) { const bf16x8 fa = *(const LAS bf16x8*)(L + KSI + off_b(16 * tj + fr, 4 * ks + fq)), fb = *(const LAS bf16x8*)(L + QS + off_b(16 * ti + fr, 4 * ks + fq));
                        acc = __builtin_amdgcn_mfma_f32_16x16x32_bf16(fa, fb, acc, 0, 0, 0); } }
                const int i = 16 * ti + fr, j0 = 16 * tj + 4 * fq; const float gi = gs[i]; float o[4];
#pragma unroll
                for (int e = 0; e < 4; ++e) { const int j = j0 + e; o[e] = (j <= i) ? acc[e] * __expf(gi - gs[j]) : 0.f; }
                *(LAS v2u*)(L + ATT + off64(i, j0 >> 3) + (j0 & 4) * 2) = (v2u){pk2(o[0], o[1]), pk2(o[2], o[3])}; }
            bf16x8 kf[2];
#pragma unroll
            for (int ks = 0; ks < 2; ++ks) kf[ks] = tr_frag(LB + KSI + tr_addr_b(lane, wave, ks, 0), LB + KSI + tr_addr_b(lane, wave, ks, 1));
#pragma unroll
            for (int ti = 0; ti < 4; ++ti) { pg8::f32x4 acc = {0.f, 0.f, 0.f, 0.f};
#pragma unroll
                for (int ks = 0; ks < 2; ++ks) { const bf16x8 fb = *(const LAS bf16x8*)(L + TP + off64(16 * ti + fr, 4 * ks + fq)); acc = __builtin_amdgcn_mfma_f32_16x16x32_bf16(kf[ks], fb, acc, 0, 0, 0); }
                const int i = 16 * ti + fr, c0 = 16 * wave + 4 * fq;
                *(LAS v2u*)(L + NW + off_b(i, c0 >> 3) + (c0 & 4) * 2) = (v2u){pk2(-acc[0], -acc[1]), pk2(-acc[2], -acc[3])}; }
            pg8::f32x4 oacc = {0.f, 0.f, 0.f, 0.f}; const int otv = wave >> 2, oti = wave & 3;
#pragma unroll
            for (int ks = 0; ks < 4; ++ks) { const bf16x8 fa = *(const LAS bf16x8*)(L + STI + off_b(16 * otv + fr, 4 * ks + fq)), fb = *(const LAS bf16x8*)(L + QS + off_b(16 * oti + fr, 4 * ks + fq));
                oacc = __builtin_amdgcn_mfma_f32_16x16x32_bf16(fa, fb, oacc, 0, 0, 0); }
            { const float e = eg[16 * oti + fr]; oacc = oacc * e; }
            __syncthreads();
            { const int ti = wave >> 1, tv = wave & 1; pg8::f32x4 acc = {0.f, 0.f, 0.f, 0.f};
#pragma unroll
              for (int ks = 0; ks < 2; ++ks) { const bf16x8 fa = *(const LAS bf16x8*)(L + TPP + off64(16 * ti + fr, 4 * ks + fq)); const bf16x8 fb = tr_frag(LB + VS + tr_addr_v(lane, tv, ks, 0), LB + VS + tr_addr_v(lane, tv, ks, 1));
                  acc = __builtin_amdgcn_mfma_f32_16x16x32_bf16(fa, fb, acc, 0, 0, 0); }
#pragma unroll
              for (int ks = 0; ks < 4; ++ks) { const bf16x8 fa = *(const LAS bf16x8*)(L + NW + off_b(16 * ti + fr, 4 * ks + fq)), fb = *(const LAS bf16x8*)(L + STI + off_b(16 * tv + fr, 4 * ks + fq));
                  acc = __builtin_amdgcn_mfma_f32_16x16x32_bf16(fa, fb, acc, 0, 0, 0); }
              const int v = 16 * tv + fr, i0 = 16 * ti + 4 * fq; const f32x4 d4 = *(const LAS f32x4*)(dg + i0);
              *(LAS v2u*)(L + VN1 + off64(v, i0 >> 3) + (i0 & 4) * 2) = (v2u){pk2(acc[0], acc[1]), pk2(acc[2], acc[3])};
              *(LAS v2u*)(L + VN2 + off64(v, i0 >> 3) + (i0 & 4) * 2) = (v2u){pk2(acc[0] * d4.x, acc[1] * d4.y), pk2(acc[2] * d4.z, acc[3] * d4.w)}; }
            __syncthreads();
#pragma unroll
            for (int ks = 0; ks < 2; ++ks) { const bf16x8 fa = *(const LAS bf16x8*)(L + VN1 + off64(16 * otv + fr, 4 * ks + fq)), fb = *(const LAS bf16x8*)(L + ATT + off64(16 * oti + fr, 4 * ks + fq));
                oacc = __builtin_amdgcn_mfma_f32_16x16x32_bf16(fa, fb, oacc, 0, 0, 0); }
            if (nm >= 4) { const int i = 16 * oti + fr, v0 = 16 * otv + 4 * fq; const int tok = tok0 + (dir == 0 ? i : 63 - i);
                *(GAS v2u*)(Oout + (size_t)tok * 1024 + h * 128 + NV * vs + v0) = (v2u){pk2(oacc[0], oacc[1]), pk2(oacc[2], oacc[3])}; }
#pragma unroll
            for (int tv = 0; tv < 2; ++tv) { pg8::f32x4 acc = Sacc[tv] * dlast;
#pragma unroll
                for (int ks = 0; ks < 2; ++ks) { const bf16x8 fb = *(const LAS bf16x8*)(L + VN2 + off64(16 * tv + fr, 4 * ks + fq)); acc = __builtin_amdgcn_mfma_f32_16x16x32_bf16(kf[ks], fb, acc, 0, 0, 0); }
                Sacc[tv] = acc; }
            __syncthreads();
#pragma unroll
            for (int tv = 0; tv < 2; ++tv) { const int v = 16 * tv + fr, c0 = 16 * wave + 4 * fq;
                *(LAS v2u*)(L + STI + off_b(v, c0 >> 3) + (c0 & 4) * 2) = (v2u){pk2(Sacc[tv][0], Sacc[tv][1]), pk2(Sacc[tv][2], Sacc[tv][3])}; }
        }
#undef P4_ISSUE
    }
}
struct EpiStore {
    static constexpr bool PERM = true, AFTER_DRAIN = false;
    bf16* O; int ldc;
    __device__ __forceinline__ void operator()(const pg8::f32x4 (&acc)[2][2][4][2], const pg8::Unit& u, int wr, int wc, int fr, int fq) const {
        const int row0 = u.pm * 256 + wr * 64 + fr, col0 = u.pn * 256 + wc * 32 + 8 * fq;
#pragma unroll
        for (int ai = 0; ai < 2; ++ai)
#pragma unroll
            for (int m = 0; m < 4; ++m) { bf16* rowp = O + (size_t)(row0 + ai * 128 + m * 16) * ldc + col0;
#pragma unroll
                for (int bj = 0; bj < 2; ++bj) { const pg8::f32x4 v0 = acc[ai][bj][m][0], v1 = acc[ai][bj][m][1];
                    pg8::u32x4 w; w.x = pg8::cvt_pk_bf16(v0[0], v0[1]); w.y = pg8::cvt_pk_bf16(v0[2], v0[3]); w.z = pg8::cvt_pk_bf16(v1[0], v1[1]); w.w = pg8::cvt_pk_bf16(v1[2], v1[3]);
                    *(pg8::u32x4*)(rowp + bj * 128) = w; } }
    }
};
constexpr size_t WS_NA = 68 * MiB, WS_NB = 100 * MiB;
constexpr size_t WS_ZH = 106 * MiB;
constexpr size_t WS_OBF = 4 * MiB, WS_OBB = 36 * MiB;
__device__ __forceinline__ void combine_norm(Frame& F, const bf16* Of, const bf16* Ob, const float* nw, bf16* N) {
    const int gw = F.vcu * NWAVES + F.wave, NGW = F.G * NWAVES; const int lane = F.lane;
    f32x4 w4[4];
#pragma unroll
    for (int j = 0; j < 4; ++j) w4[j] = *(const f32x4*)(nw + (16 * lane) % 128 + 4 * j);
    for (int t = gw; t < ML; t += NGW) {
        const size_t o = (size_t)t * 1024 + 16 * lane;
        const v4u a0 = *(const GAS v4u*)(Of + o), a1 = *(const GAS v4u*)(Of + o + 8), b0 = *(const GAS v4u*)(Ob + o), b1 = *(const GAS v4u*)(Ob + o + 8);
        const unsigned aw[8] = {a0.x, a0.y, a0.z, a0.w, a1.x, a1.y, a1.z, a1.w}, bw[8] = {b0.x, b0.y, b0.z, b0.w, b1.x, b1.y, b1.z, b1.w};
        float v[16]; float s = 0.f;
#pragma unroll
        for (int e = 0; e < 8; ++e) { v[2 * e] = bflo(aw[e]) + bflo(bw[e]); v[2 * e + 1] = bfhi(aw[e]) + bfhi(bw[e]); s += v[2 * e] * v[2 * e] + v[2 * e + 1] * v[2 * e + 1]; }
        s += __shfl_xor(s, 1); s += __shfl_xor(s, 2); s += __shfl_xor(s, 4);
        const float inv = 1.0f / sqrtf(s * (1.f / 128.f) + EPS);
        const float wv[16] = {w4[0].x, w4[0].y, w4[0].z, w4[0].w, w4[1].x, w4[1].y, w4[1].z, w4[1].w, w4[2].x, w4[2].y, w4[2].z, w4[2].w, w4[3].x, w4[3].y, w4[3].z, w4[3].w};
        unsigned ow[8];
#pragma unroll
        for (int e = 0; e < 8; ++e) ow[e] = pk2(v[2 * e] * inv * wv[2 * e], v[2 * e + 1] * inv * wv[2 * e + 1]);
        *(GAS v4u*)(N + o) = (v4u){ow[0], ow[1], ow[2], ow[3]}; *(GAS v4u*)(N + o + 8) = (v4u){ow[4], ow[5], ow[6], ow[7]};
    }
}
namespace hscan {
constexpr int QT = 0, KT = 16384, AI = 32768, STI = 40960, VS0 = 49152, VS1 = 53248, GS = 57344;
constexpr int NV = 32, NITEMS = NB * NH * 2 * 4;
}
__device__ __forceinline__ void p7_hgrn_scan(Frame& F) {
    using namespace hscan;
    const bf16* Zh = (const bf16*)(F.ws + WS_ZH); const float* lbp = (const float*)(F.ws + WS_LB);
    LAS unsigned char* L = F.lds; const unsigned LB = (unsigned)(unsigned long long)F.lds;
    LAS float* gsum = (LAS float*)(L + GS);
    const int wave = F.wave;
    for (int item = F.vcu; item < NITEMS; item += F.G) {
        int tid = F.tid; asm volatile("" : "+v"(tid));
        const int lane = tid & 63, fr = lane & 15, fq = lane >> 4, kp = lane;
        const int vs = item & 3, dir = (item >> 2) & 1, h = (item >> 3) & 7, b = item >> 6;
        bf16* Oout = (bf16*)(F.ws + (dir == 0 ? WS_OBF : WS_OBB));
        const float lb0 = lbp[dir * 1024 + h * 128 + 2 * kp], lb1 = lbp[dir * 1024 + h * 128 + 2 * kp + 1];
        pg8::f32x4 Sacc[2] = {{0.f, 0.f, 0.f, 0.f}, {0.f, 0.f, 0.f, 0.f}};
        __syncthreads();
        unsigned pf[8], pqb[8]; v4u pv;
#define P7_ISSUE(s_) do { const int nm_ = dir == 0 ? (s_) : ((s_) < 4 ? 3 - (s_) : 67 - ((s_) - 4)); const int tk0_ = chunk_tok0(b, nm_); \
        _Pragma("unroll") for (int i = 0; i < 8; ++i) { const int t = 8 * wave + i; const size_t ro = (size_t)(tk0_ + (dir == 0 ? t : 63 - t)) * 4096; \
            pf[i] = *(const GAS unsigned*)(Zh + ro + dir * 1024 + h * 128 + 2 * kp); pqb[i] = *(const GAS unsigned*)(Zh + ro + 2048 + h * 128 + 2 * kp); } \
        if (tid < 256) { const int j = tid >> 2, ch = tid & 3; pv = *(const GAS v4u*)(Zh + (size_t)(tk0_ + (dir == 0 ? j : 63 - j)) * 4096 + 3072 + h * 128 + NV * vs + ch * 8); } } while (0)
        P7_ISSUE(0);
        for (int s = 0; s < NCH; ++s) {
            const int nm = dir == 0 ? s : (s < 4 ? 3 - s : 67 - (s - 4)); const int tok0 = chunk_tok0(b, nm);
            const int VS = (s & 1) ? VS1 : VS0;
            float cum0[8], cum1[8], kk0[8], kk1[8], q0[8], q1[8];
            { float c0 = 0.f, c1 = 0.f;
#pragma unroll
              for (int i = 0; i < 8; ++i) { const float z0 = bflo(pf[i]), z1 = bfhi(pf[i]);
                  const float em0 = __expf(-z0), em1 = __expf(-z1), sg0 = 1.f / (1.f + em0), sg1 = 1.f / (1.f + em1);
                  c0 += __logf(lb0 + (1.f - lb0) * sg0); c1 += __logf(lb1 + (1.f - lb1) * sg1); cum0[i] = c0; cum1[i] = c1;
                  kk0[i] = (1.f - lb0) * em0 * sg0; kk1[i] = (1.f - lb1) * em1 * sg1;
                  const float y0 = bflo(pqb[i]), y1 = bfhi(pqb[i]); q0[i] = y0 / (1.f + __expf(-y0)) * 0.08838834764831845f; q1[i] = y1 / (1.f + __expf(-y1)) * 0.08838834764831845f; }
              gsum[wave * 128 + 2 * kp] = c0; gsum[wave * 128 + 2 * kp + 1] = c1; }
            if (tid < 256) { const int j = tid >> 2, ch = tid & 3; *(LAS v4u*)(L + VS + off_v(j, ch)) = pv; }
            __syncthreads();
            float eblast[4], ebd[4];
            { float pre0 = 0.f, pre1 = 0.f, ref0 = 0.f, ref1 = 0.f;
#pragma unroll
              for (int g = 0; g < 8; ++g) { const float a0 = gsum[g * 128 + 2 * kp], a1 = gsum[g * 128 + 2 * kp + 1]; if (g < wave) { pre0 += a0; pre1 += a1; } if (g < 4) { ref0 += a0; ref1 += a1; } }
#pragma unroll
              for (int i = 0; i < 8; ++i) { const int t = 8 * wave + i; const float d0 = pre0 + cum0[i] - ref0, d1 = pre1 + cum1[i] - ref1;
                  const float e0 = __expf(d0), e1 = __expf(d1), r0 = __expf(-d0), r1 = __expf(-d1);
                  *(LAS unsigned*)(L + QT + off_b(t, kp >> 2) + (kp & 3) * 4) = pk2(q0[i] * e0, q1[i] * e1);
                  *(LAS unsigned*)(L + KT + off_b(t, kp >> 2) + (kp & 3) * 4) = pk2(kk0[i] * r0, kk1[i] * r1); }
              const int c0 = 16 * wave + 4 * fq; float ebr[4];
#pragma unroll
              for (int e = 0; e < 4; ++e) { float br = 0.f, bl = 0.f;
#pragma unroll
                  for (int g = 0; g < 8; ++g) { const float a = gsum[g * 128 + c0 + e]; bl += a; if (g < 4) br += a; }
                  ebr[e] = __expf(br); eblast[e] = __expf(bl); ebd[e] = __expf(bl - br); }
#pragma unroll
              for (int tv = 0; tv < 2; ++tv) { const int v = 16 * tv + fr;
                  *(LAS v2u*)(L + STI + off_b(v, c0 >> 3) + (c0 & 4) * 2) = (v2u){pk2(Sacc[tv][0] * ebr[0], Sacc[tv][1] * ebr[1]), pk2(Sacc[tv][2] * ebr[2], Sacc[tv][3] * ebr[3])}; } }
            __syncthreads();
            if (s + 1 < NCH) P7_ISSUE(s + 1);
#pragma unroll
            for (int tt = 0; tt < 2; ++tt) { const int t = 2 * wave + tt, ts = t >> 2, ti = t & 3;
                pg8::f32x4 acc = {0.f, 0.f, 0.f, 0.f};
                if (ts <= ti) {
#pragma unroll
                    for (int ks = 0; ks < 4; ++ks) { const bf16x8 fa = *(const LAS bf16x8*)(L + KT + off_b(16 * ts + fr, 4 * ks + fq)), fb = *(const LAS bf16x8*)(L + QT + off_b(16 * ti + fr, 4 * ks + fq));
                        acc = __builtin_amdgcn_mfma_f32_16x16x32_bf16(fa, fb, acc, 0, 0, 0); } }
                const int i = 16 * ti + fr, j0 = 16 * ts + 4 * fq; float o[4];
#pragma unroll
                for (int e = 0; e < 4; ++e) o[e] = (j0 + e <= i) ? acc[e] : 0.f;
                *(LAS v2u*)(L + AI + off64(i, j0 >> 3) + (j0 & 4) * 2) = (v2u){pk2(o[0], o[1]), pk2(o[2], o[3])}; }
            pg8::f32x4 oacc = {0.f, 0.f, 0.f, 0.f}; const int otv = wave >> 2, oti = wave & 3;
#pragma unroll
            for (int ks = 0; ks < 4; ++ks) { const bf16x8 fa = *(const LAS bf16x8*)(L + STI + off_b(16 * otv + fr, 4 * ks + fq)), fb = *(const LAS bf16x8*)(L + QT + off_b(16 * oti + fr, 4 * ks + fq));
                oacc = __builtin_amdgcn_mfma_f32_16x16x32_bf16(fa, fb, oacc, 0, 0, 0); }
            { bf16x8 kf[2], vf[2][2];
#pragma unroll
              for (int ks = 0; ks < 2; ++ks) { kf[ks] = tr_frag(LB + KT + tr_addr_b(lane, wave, ks, 0), LB + KT + tr_addr_b(lane, wave, ks, 1));
#pragma unroll
                  for (int tv = 0; tv < 2; ++tv) vf[tv][ks] = tr_frag(LB + VS + tr_addr_v(lane, tv, ks, 0), LB + VS + tr_addr_v(lane, tv, ks, 1)); }
#pragma unroll
              for (int tv = 0; tv < 2; ++tv) { pg8::f32x4 p = {0.f, 0.f, 0.f, 0.f};
#pragma unroll
                  for (int ks = 0; ks < 2; ++ks) p = __builtin_amdgcn_mfma_f32_16x16x32_bf16(kf[ks], vf[tv][ks], p, 0, 0, 0);
#pragma unroll
                  for (int e = 0; e < 4; ++e) Sacc[tv][e] = eblast[e] * Sacc[tv][e] + ebd[e] * p[e]; } }
            __syncthreads();
#pragma unroll
            for (int ks = 0; ks < 2; ++ks) { const bf16x8 fa = tr_frag(LB + VS + tr_addr_v(lane, otv, ks, 0), LB + VS + tr_addr_v(lane, otv, ks, 1)); const bf16x8 fb = *(const LAS bf16x8*)(L + AI + off64(16 * oti + fr, 4 * ks + fq));
                oacc = __builtin_amdgcn_mfma_f32_16x16x32_bf16(fa, fb, oacc, 0, 0, 0); }
            if (nm >= 4) { const int i = 16 * oti + fr, v0 = 16 * otv + 4 * fq; const int tok = tok0 + (dir == 0 ? i : 63 - i);
                *(GAS v2u*)(Oout + (size_t)tok * 1024 + h * 128 + NV * vs + v0) = (v2u){pk2(oacc[0], oacc[1]), pk2(oacc[2], oacc[3])}; }
        }
#undef P7_ISSUE
    }
}
constexpr size_t WS_SG = 132 * MiB;
constexpr size_t WS_TMP = 4 * MiB;
constexpr size_t WS_MB = 196 * MiB;
constexpr size_t WS_W2T = 228 * MiB;
constexpr size_t WS_H2 = 68 * MiB;
constexpr size_t WS_HID = 100 * MiB;

struct EpiG3 {
    static constexpr bool PERM = true, AFTER_DRAIN = false;
    unsigned char* ws;
    __device__ __forceinline__ void operator()(const pg8::f32x4 (&acc)[2][2][4][2], const pg8::Unit& u, int wr, int wc, int fr, int fq) const {
        const int row0 = u.pm * 256 + wr * 64 + fr;
        const bool gate = u.pn >= 8;
        const size_t boff = gate ? WS_SG : (u.pn >= 4 ? WS_NB : WS_NA); bf16* base = (bf16*)(ws + boff); const int ldc = gate ? 2048 : 1024;
        const int col0 = (gate ? (u.pn - 8) : (u.pn & 3)) * 256 + wc * 32 + 8 * fq;
#pragma unroll
        for (int ai = 0; ai < 2; ++ai)
#pragma unroll
            for (int m = 0; m < 4; ++m) { bf16* rowp = base + (size_t)(row0 + ai * 128 + m * 16) * ldc + col0;
#pragma unroll
                for (int bj = 0; bj < 2; ++bj) { const pg8::f32x4 v0 = acc[ai][bj][m][0], v1 = acc[ai][bj][m][1];
                    float o[8] = {v0[0], v0[1], v0[2], v0[3], v1[0], v1[1], v1[2], v1[3]};
                    if (gate) {
#pragma unroll
                        for (int e = 0; e < 8; ++e) o[e] = sigm(o[e]);
                    } else { const v4u nv = *(const GAS v4u*)(rowp + bj * 128); const unsigned nw[4] = {nv.x, nv.y, nv.z, nv.w};
#pragma unroll
                        for (int e = 0; e < 4; ++e) { o[2 * e] = bflo(nw[e]) * siluf(o[2 * e]); o[2 * e + 1] = bfhi(nw[e]) * siluf(o[2 * e + 1]); } }
                    pg8::u32x4 w; w.x = pk2(o[0], o[1]); w.y = pk2(o[2], o[3]); w.z = pk2(o[4], o[5]); w.w = pk2(o[6], o[7]);
                    *(pg8::u32x4*)(rowp + bj * 128) = w; } }
    }
};
template <int PASS> struct EpiMerge {
    static constexpr bool PERM = false, AFTER_DRAIN = false;
    const bf16* SG; float* tmp; bf16* Mb;
    __device__ __forceinline__ void operator()(const pg8::f32x4 (&acc)[2][2][4][2], const pg8::Unit& u, int wr, int wc, int fr, int fq) const {
        const int row0 = u.pm * 256 + wr * 64 + fr, col0 = u.pn * 256 + wc * 32 + 4 * fq;
#pragma unroll
        for (int ai = 0; ai < 2; ++ai)
#pragma unroll
            for (int m = 0; m < 4; ++m) { const size_t r = (size_t)(row0 + ai * 128 + m * 16);
#pragma unroll
                for (int bj = 0; bj < 2; ++bj)
#pragma unroll
                    for (int n = 0; n < 2; ++n) { const int c = col0 + bj * 128 + n * 16; const pg8::f32x4 v = acc[ai][bj][m][n];
                        const v2u sg = *(const GAS v2u*)(SG + r * 2048 + (PASS ? 1024 : 0) + c);
                        f32x4 o; o.x = bflo(sg.x) * v[0]; o.y = bfhi(sg.x) * v[1]; o.z = bflo(sg.y) * v[2]; o.w = bfhi(sg.y) * v[3];
                        if (PASS == 0) *(f32x4*)(tmp + r * 1024 + c) = o;
                        else { const f32x4 t = *(const f32x4*)(tmp + r * 1024 + c); o = o + t; *(GAS v2u*)(Mb + r * 1024 + c) = (v2u){pk2(o.x, o.y), pk2(o.z, o.w)}; } } }
    }
};
struct EpiF32S {
    static constexpr bool PERM = false, AFTER_DRAIN = false;
    float* C; int ldc;
    __device__ __forceinline__ void operator()(const pg8::f32x4 (&acc)[2][2][4][2], const pg8::Unit& u, int wr, int wc, int fr, int fq) const {
        const int row0 = u.pm * 256 + wr * 64 + fr, col0 = u.pn * 256 + wc * 32 + 4 * fq;
#pragma unroll
        for (int ai = 0; ai < 2; ++ai)
#pragma unroll
            for (int m = 0; m < 4; ++m) { float* rowp = C + (size_t)(row0 + ai * 128 + m * 16) * ldc + col0;
#pragma unroll
                for (int bj = 0; bj < 2; ++bj)
#pragma unroll
                    for (int n = 0; n < 2; ++n) *(pg8::f32x4*)(rowp + bj * 128 + n * 16) = acc[ai][bj][m][n]; }
    }
};
struct EpiRelu2 {
    static constexpr bool PERM = true, AFTER_DRAIN = false;
    bf16* O; int ldc;
    __device__ __forceinline__ void operator()(const pg8::f32x4 (&acc)[2][2][4][2], const pg8::Unit& u, int wr, int wc, int fr, int fq) const {
        const int row0 = u.pm * 256 + wr * 64 + fr, col0 = u.pn * 256 + wc * 32 + 8 * fq;
#pragma unroll
        for (int ai = 0; ai < 2; ++ai)
#pragma unroll
            for (int m = 0; m < 4; ++m) { bf16* rowp = O + (size_t)(row0 + ai * 128 + m * 16) * ldc + col0;
#pragma unroll
                for (int bj = 0; bj < 2; ++bj) { pg8::f32x4 v0 = acc[ai][bj][m][0], v1 = acc[ai][bj][m][1];
#pragma unroll
                    for (int e = 0; e < 4; ++e) { const float a = fmaxf(v0[e], 0.f), b = fmaxf(v1[e], 0.f); v0[e] = a * a; v1[e] = b * b; }
                    pg8::u32x4 w; w.x = pg8::cvt_pk_bf16(v0[0], v0[1]); w.y = pg8::cvt_pk_bf16(v0[2], v0[3]); w.z = pg8::cvt_pk_bf16(v1[0], v1[1]); w.w = pg8::cvt_pk_bf16(v1[2], v1[3]);
                    *(pg8::u32x4*)(rowp + bj * 128) = w; } }
    }
};
__device__ __forceinline__ void rowwise_resid(Frame& F, const float* xin, const float* r, const float* g, int gt_off, float* xo, bf16* H2, const float* g2, int sh_off, int sc_off) {
    const int gw = F.vcu * NWAVES + F.wave, NGW = F.G * NWAVES; const float* mod = (const float*)(F.ws + WS_MOD);
    for (int m = gw; m < ML; m += NGW) {
        const float* mr = mod + (size_t)(m >> 12) * 6 * D;
        const GAS f32x4* rp = (const GAS f32x4*)(r + (size_t)m * D) + F.lane; const GAS f32x4* xp = (const GAS f32x4*)(xin + (size_t)m * D) + F.lane;
        f32x4 v[4], xv[4]; float s = 0.f;
#pragma unroll
        for (int j = 0; j < 4; ++j) { v[j] = rp[64 * j]; xv[j] = xp[64 * j]; s += (v[j].x * v[j].x + v[j].y * v[j].y) + (v[j].z * v[j].z + v[j].w * v[j].w); }
        const float inv = 1.0f / sqrtf(wave_sum(s) * (1.f / D) + EPS); float s2 = 0.f;
        GAS f32x4* op = (GAS f32x4*)(xo + (size_t)m * D) + F.lane;
#pragma unroll
        for (int j = 0; j < 4; ++j) { const int col = 4 * F.lane + 256 * j; const f32x4 gg = *(const f32x4*)(g + col), gt = *(const f32x4*)(mr + gt_off + col);
            xv[j] = xv[j] + gt * (v[j] * inv * gg); op[64 * j] = xv[j]; s2 += (xv[j].x * xv[j].x + xv[j].y * xv[j].y) + (xv[j].z * xv[j].z + xv[j].w * xv[j].w); }
        if (H2) { const float inv2 = 1.0f / sqrtf(wave_sum(s2) * (1.f / D) + EPS); GAS v2u* o8 = (GAS v2u*)(H2 + (size_t)m * D) + F.lane;
#pragma unroll
            for (int j = 0; j < 4; ++j) { const int col = 4 * F.lane + 256 * j; const f32x4 gg = *(const f32x4*)(g2 + col), sh = *(const f32x4*)(mr + sh_off + col), sc = *(const f32x4*)(mr + sc_off + col);
                const f32x4 h = (xv[j] * inv2 * gg) * (sc + 1.0f) + sh; o8[64 * j] = (v2u){pk2(h.x, h.y), pk2(h.z, h.w)}; } }
    }
}
__device__ __forceinline__ void w2_transpose(Frame& F) {
    LAS float* scr = (LAS float*)(F.lds + F.wave * 8704); const int gw = F.vcu * NWAVES + F.wave, NGW = F.G * NWAVES;
    bf16* W2T = (bf16*)(F.ws + WS_W2T);
    for (int it = gw; it < 64 * 32; it += NGW) { const int kb = it / 32, nb = it % 32; p0_transpose_item(F.w2, D, 64 * kb, 32 * nb, W2T, FF, 32 * nb, scr, F.lane); }
}
constexpr int NPH = 16;
__global__ void __launch_bounds__(NTHR, 2) mk_fwd(Args args) {
    extern __shared__ __attribute__((aligned(16))) unsigned char lds[];
    Frame F;
    F.lds = (LAS unsigned char*)lds; F.MISC = (volatile LAS unsigned*)(F.lds + MISC_OFF);
    F.tid = threadIdx.x; F.lane = F.tid & 63; F.wave = __builtin_amdgcn_readfirstlane(F.tid >> 6);
    F.G = gridDim.x; { const int bx = blockIdx.x; F.vcu = (F.G % 8 == 0) ? (bx % 8) * (F.G / 8) + bx / 8 : bx; }
    F.ws = args.ws; F.out = args.out; F.dob = (unsigned char*)args.out; F.ctl = (gu32*)(args.ws + WS_CTL);
    F.x = args.in[0]; F.c = args.in[1]; F.ctx = args.in[2]; F.c_ctx = args.in[3]; F.w_ada = args.in[4]; F.b_ada = args.in[5]; F.norm_g = args.in[6]; F.w_in = args.in[7];
    F.conv_w = args.in[8]; F.a_log = args.in[9]; F.dt_bias = args.in[10]; F.gdn_nw = args.in[11]; F.lb_logits = args.in[12]; F.hgrn_nw = args.in[13]; F.w_ba = args.in[14];
    F.w_bb = args.in[15]; F.w_out = args.in[16]; F.w1 = args.in[17]; F.w2 = args.in[18];
    for (int u = F.tid; u < (LDS_BYTES - MISC_OFF) / 4; u += NTHR) ((LAS unsigned*)(F.lds + MISC_OFF))[u] = 0u;
    __syncthreads();
    XcdBarrier bar = xcd_barrier_post((unsigned*)(F.ctl + CW_BAR) + args.li * XCD_BAR_WORDS, F.MISC + 8);
    const int lo = args.ph_lo, hi = args.ph_hi;
#define IN(k) (lo <= (k) && (k) < hi)
#define SEAM(k) do { if ((k) + 1 < hi) xcd_barrier(bar); } while (0)
    bf16* H = (bf16*)(F.dob + DO_H); bf16* WinT = (bf16*)(F.dob + DO_WIN);
    if (IN(0)) { p0_prologue(F); SEAM(0); }
    if (IN(1)) { p1_hrows(F); SEAM(1); }
    if (IN(2)) {
        pg8::Gemm g{H, WinT + (size_t)R_QKV * D, MR, N_G1, D}; pg8::StaticOrder S; S.init(MR, N_G1, F.G, (int)blockIdx.x);
        EpiG1 E{(bf16*)(F.ws + WS_ZQ), (float*)(F.ws + WS_LA), (float*)(F.ws + WS_BE), F.a_log, F.dt_bias};
        pg8::gemm_phase<EpiG1, pg8::StaticOrder, true, true>(F.lds, g, S, E);
        SEAM(2);
    }
    if (IN(3)) { p3_gdn_prep(F); SEAM(3); }
    if (IN(4)) { p4_gdn_scan(F); SEAM(4); }
    if (IN(5)) { combine_norm(F, (const bf16*)(F.ws + WS_OAF), (const bf16*)(F.ws + WS_OAB), F.gdn_nw, (bf16*)(F.ws + WS_NA)); SEAM(5); }
    if (IN(6)) {
        pg8::Gemm g{H, WinT + (size_t)R_G2 * D, MR, N_G2, D}; pg8::StaticOrder S; S.init(MR, N_G2, F.G, (int)blockIdx.x);
        EpiStore E{(bf16*)(F.ws + WS_ZH), N_G2};
        pg8::gemm_phase<EpiStore, pg8::StaticOrder, true, true>(F.lds, g, S, E);
        SEAM(6);
    }
    if (IN(7)) { p7_hgrn_scan(F); SEAM(7); }
    if (IN(8)) { combine_norm(F, (const bf16*)(F.ws + WS_OBF), (const bf16*)(F.ws + WS_OBB), F.hgrn_nw, (bf16*)(F.ws + WS_NB)); w2_transpose(F); SEAM(8); }
    bf16* WaT = (bf16*)(F.ws + WS_WSM); bf16* WbT = WaT + (size_t)D * D; bf16* WoT = WbT + (size_t)D * D; bf16* W1T = WoT + (size_t)D * D;
    if (IN(9)) {
        pg8::Gemm g{H, WinT + (size_t)R_GA * D, ML, N_G3, D}; pg8::StaticOrder S; S.init(ML, N_G3, F.G, (int)blockIdx.x);
        EpiG3 E{F.ws};
        pg8::gemm_phase<EpiG3, pg8::StaticOrder, true, true>(F.lds, g, S, E);
        SEAM(9);
    }
    if (IN(10)) {
        pg8::StaticOrder S; S.init(ML, D, F.G, (int)blockIdx.x);
        { pg8::Gemm g{(const bf16*)(F.ws + WS_NA), WaT, ML, D, D}; EpiMerge<0> E{(const bf16*)(F.ws + WS_SG), (float*)(F.ws + WS_TMP), (bf16*)(F.ws + WS_MB)};
          pg8::gemm_phase<EpiMerge<0>, pg8::StaticOrder, true, true>(F.lds, g, S, E); }
        __syncthreads();
        { pg8::Gemm g{(const bf16*)(F.ws + WS_NB), WbT, ML, D, D}; EpiMerge<1> E{(const bf16*)(F.ws + WS_SG), (float*)(F.ws + WS_TMP), (bf16*)(F.ws + WS_MB)};
          pg8::gemm_phase<EpiMerge<1>, pg8::StaticOrder, true, true>(F.lds, g, S, E); }
        SEAM(10);
    }
    if (IN(11)) {
        pg8::Gemm g{(const bf16*)(F.ws + WS_MB), WoT, ML, D, D}; pg8::StaticOrder S; S.init(ML, D, F.G, (int)blockIdx.x);
        EpiF32S E{(float*)(F.ws + WS_TMP), D};
        pg8::gemm_phase<EpiF32S, pg8::StaticOrder, true, true>(F.lds, g, S, E);
        SEAM(11);
    }
    if (IN(12)) { rowwise_resid(F, F.x, (const float*)(F.ws + WS_TMP), F.norm_g + D, 2 * D, F.out, (bf16*)(F.ws + WS_H2), F.norm_g + 2 * D, 3 * D, 4 * D); SEAM(12); }
    if (IN(13)) {
        pg8::Gemm g{(const bf16*)(F.ws + WS_H2), W1T, ML, FF, D}; pg8::StaticOrder S; S.init(ML, FF, F.G, (int)blockIdx.x);
        EpiRelu2 E{(bf16*)(F.ws + WS_HID), FF};
        pg8::gemm_phase<EpiRelu2, pg8::StaticOrder, true, true>(F.lds, g, S, E);
        SEAM(13);
    }
    if (IN(14)) {
        pg8::Gemm g{(const bf16*)(F.ws + WS_HID), (const bf16*)(F.ws + WS_W2T), ML, D, FF}; pg8::StaticOrder S; S.init(ML, D, F.G, (int)blockIdx.x);
        EpiF32S E{(float*)(F.ws + WS_TMP), D};
        pg8::gemm_phase<EpiF32S, pg8::StaticOrder, true, true>(F.lds, g, S, E);
        SEAM(14);
    }
    if (IN(15)) { rowwise_resid(F, F.out, (const float*)(F.ws + WS_TMP), F.norm_g + 3 * D, 5 * D, F.out, nullptr, nullptr, 0, 0); }
#undef IN
#undef SEAM
}
}
static int fk_grid(hipStream_t) {
    static int grid = 0;
    if (grid == 0) {
        int dev = 0, cus = 0, per_cu = 0;
        if (hipGetDevice(&dev) != hipSuccess || hipDeviceGetAttribute(&cus, hipDeviceAttributeMultiprocessorCount, dev) != hipSuccess) { grid = -1; return grid; }
        if (hipFuncSetAttribute((const void*)fk::mk_fwd, hipFuncAttributeMaxDynamicSharedMemorySize, fk::LDS_BYTES) != hipSuccess) { fprintf(stderr, "hipFuncSetAttribute failed\n"); grid = -1; return grid; }
        if (hipOccupancyMaxActiveBlocksPerMultiprocessor(&per_cu, (const void*)fk::mk_fwd, fk::NTHR, fk::LDS_BYTES) != hipSuccess || per_cu < 1) { fprintf(stderr, "occupancy query: %d blocks/CU\n", per_cu); (void)hipGetLastError(); grid = -1; return grid; }
        grid = cus;
    }
    return grid;
}
static void fk_launch(const fk::Args& a0, int lo, int hi, int li, int grid, hipStream_t stream) {
    fk::Args a = a0; a.ph_lo = lo; a.ph_hi = hi; a.li = li; a.pad = 0;
    hipLaunchKernelGGL(fk::mk_fwd, dim3(grid), dim3(fk::NTHR), fk::LDS_BYTES, stream, a);
}
extern "C" void kernel_launch(void* const* d_in, const int* in_sizes, int n_in, void* d_out, int out_size, void* d_ws, size_t ws_size, hipStream_t stream) {
    const Ins I = get_ins(d_in); float* out = (float*)d_out; char* ws = (char*)d_ws;
    if (n_in != 19 || ws_size < fk::WS_END || out_size != fk::ML * fk::D) { fprintf(stderr, "kernel_launch: unexpected sizes\n"); return; }
#if MODE == 0
    OB B; if (!ob_carve(B, ws, ws_size)) return;
    oracle_pre(B, I, stream);
    for (int b = 0; b < nv::NB; ++b) oracle_batch(B, b, 99, I, out, stream);
#else
    const int grid = fk_grid(stream); if (grid < 0) return;
    (void)hipMemsetAsync(ws + fk::WS_CTL, 0, fk::CTL_ZERO_BYTES, stream);
    fk::Args a{}; for (int i = 0; i < 19; ++i) a.in[i] = (const float*)d_in[i]; a.out = out; a.ws = (unsigned char*)d_ws;
#if MODE == 2
    fk_launch(a, 0, fk::NPH, 0, grid, stream);
#elif MODE == 3
    for (int p = 0; p < fk::NPH; ++p) fk_launch(a, p, p + 1, 0, grid, stream);
#else
    float* err = (float*)(ws + fk::WS_CTL) + fk::CW_ERR; int nerr = 0;
    const int MiB = 1 << 20;
#if DBG_STAGE == 1
    for (int p = 0; p < 3; ++p) fk_launch(a, p, p + 1, 0, grid, stream);
    { OB B; if (!ob_carve(B, ws + (size_t)106 * MiB, (size_t)150 * MiB, 1)) { fprintf(stderr, "carve\n"); return; }
      oracle_pre(B, I, stream);
      for (int b = 0; b < nv::NB; ++b) { oracle_batch(B, b, 1, I, out, stream);
        hipLaunchKernelGGL(nv::k_cmp<unsigned short>, dim3(1024), dim3(256), 0, stream, (const unsigned short*)(ws + fk::WS_ZQ), 3072, 0, B.zbuf, 3072, b, 0, nv::ROWS, 3072, 0, err + 0);
        hipLaunchKernelGGL(nv::k_cmp<float>, dim3(64), dim3(256), 0, stream, (const float*)(ws + fk::WS_LA), 16, 0, B.la, 16, b, 0, nv::ROWS, 16, 0, err + 2);
        hipLaunchKernelGGL(nv::k_cmp<float>, dim3(64), dim3(256), 0, stream, (const float*)(ws + fk::WS_BE), 16, 0, B.be, 16, b, 0, nv::ROWS, 16, 0, err + 4); }
      nerr = 3; }
#endif
#if DBG_STAGE == 2
    for (int p = 0; p < 4; ++p) fk_launch(a, p, p + 1, 0, grid, stream);
    { OB B{}; char* dob = (char*)d_out;
      B.hb = (float*)dob; B.zab = (float*)(dob + (size_t)17 * MiB); B.la = (float*)(dob + (size_t)18 * MiB); B.be = (float*)(dob + (size_t)19 * MiB); B.mod = (float*)(dob + (size_t)20 * MiB); B.lb = (float*)(dob + (size_t)21 * MiB);
      B.zbuf = (float*)(ws + (size_t)4 * MiB); B.qkvc = (float*)(ws + (size_t)55 * MiB);
      oracle_pre(B, I, stream);
      for (int b = 0; b < nv::NB; ++b) { oracle_batch(B, b, 2, I, out, stream);
        hipLaunchKernelGGL(nv::k_cmp<unsigned short>, dim3(1024), dim3(256), 0, stream, (const unsigned short*)(ws + fk::WS_QKVC), 3072, 0, B.qkvc, 3072, b, 0, nv::ROWS, 3072, 0, err + 0); }
      nerr = 1; }
#endif
#if DBG_STAGE == 3
    for (int p = 0; p < 5; ++p) fk_launch(a, p, p + 1, 0, grid, stream);
    { OB B; if (!ob_carve(B, ws + (size_t)68 * MiB, (size_t)188 * MiB, 3)) { fprintf(stderr, "carve\n"); return; }
      oracle_pre(B, I, stream);
      for (int b = 0; b < nv::NB; ++b) { oracle_batch(B, b, 3, I, out, stream);
        hipLaunchKernelGGL(nv::k_cmp2, dim3(1024), dim3(256), 0, stream, (const unsigned short*)(ws + fk::WS_OAF), (const unsigned short*)(ws + fk::WS_OAB), 1024, B.oa, 1024, b, nv::T, 1024, err + 0); }
      nerr = 1; }
#endif
#if DBG_STAGE == 4
    for (int p = 0; p < 8; ++p) fk_launch(a, p, p + 1, 0, grid, stream);
    { OB B; if (!ob_carve(B, ws + (size_t)100 * MiB, (size_t)156 * MiB, 4)) { fprintf(stderr, "carve\n"); return; }
      oracle_pre(B, I, stream);
      for (int b = 0; b < nv::NB; ++b) { oracle_batch(B, b, 4, I, out, stream);
        hipLaunchKernelGGL(nv::k_cmp2, dim3(1024), dim3(256), 0, stream, (const unsigned short*)(ws + fk::WS_OBF), (const unsigned short*)(ws + fk::WS_OBB), 1024, B.ob, 1024, b, nv::T, 1024, err + 0); }
      nerr = 1; }
#endif
    { OB B; if (!ob_carve(B, ws + (size_t)1 * MiB, ws_size - (size_t)1 * MiB)) { fprintf(stderr, "carve2\n"); return; }
      oracle_pre(B, I, stream);
      for (int b = 0; b < nv::NB; ++b) oracle_batch(B, b, 99, I, out, stream);
      hipLaunchKernelGGL(nv::k_scale_out, dim3(2048), dim3(256), 0, stream, out, (size_t)fk::ML * fk::D, err, nerr); }
#endif
#endif
}
```

```cpp
#include <hip/hip_runtime.h>
#include <stdint.h>
#include <stddef.h>
#include <cstdio>
#ifndef MODE
#define MODE 2
#endif
#ifndef DBG_STAGE
#define DBG_STAGE 4
#endif
namespace nv {
constexpr int D = 1024, T = 4096, CT = 256, NB = 4, H = 8, DK = 128, INT = 11296, ROWS = CT + T, FF = 4096;
constexpr float EPS = 1e-6f;
constexpr int C_QKV = 0, C_GA = 3072, C_AIN = 4096, C_BIN = 4112, C_FIN = 4128, C_QB = 6176, C_IB = 7200, C_GB = 8224, C_MG = 9248;

__device__ __forceinline__ float sigm(float x) { return 1.f / (1.f + expf(-x)); }
__device__ __forceinline__ float siluf(float x) { return x / (1.f + expf(-x)); }
__device__ __forceinline__ float softplusf(float x) { return fmaxf(x, 0.f) + log1pf(expf(-fabsf(x))); }

__device__ __forceinline__ float block_sum256(float v, float* red) {
#pragma unroll
    for (int o = 32; o >= 1; o >>= 1) v += __shfl_xor(v, o);
    const int w = threadIdx.x >> 6;
    __syncthreads();
    if ((threadIdx.x & 63) == 0) red[w] = v;
    __syncthreads();
    return red[0] + red[1] + red[2] + red[3];
}

__global__ __launch_bounds__(256) void k_mod(const float* c, const float* c_ctx, const float* w_ada, const float* b_ada, float* mod) {
    __shared__ float s[5][D];
    for (int i = threadIdx.x; i < 5 * D; i += 256) { const int r = i / D, k = i % D; const float x = r < 4 ? c[r * D + k] : c_ctx[k]; s[r][k] = siluf(x); }
    __syncthreads();
    const int n = blockIdx.x * 256 + threadIdx.x;
    float a0 = 0, a1 = 0, a2 = 0, a3 = 0, a4 = 0;
    for (int k = 0; k < D; ++k) { const float w = w_ada[(size_t)k * 6 * D + n]; a0 += s[0][k] * w; a1 += s[1][k] * w; a2 += s[2][k] * w; a3 += s[3][k] * w; a4 += s[4][k] * w; }
    const float b = b_ada[n];
    mod[0 * 6 * D + n] = a0 + b; mod[1 * 6 * D + n] = a1 + b; mod[2 * 6 * D + n] = a2 + b; mod[3 * 6 * D + n] = a3 + b; mod[4 * 6 * D + n] = a4 + b;
}
__global__ void k_lb(const float* logits, float* lb) {
    const int i = blockIdx.x * blockDim.x + threadIdx.x; if (i >= 2 * D) return;
    const float l0 = logits[i], l1 = logits[2 * D + i], m = fmaxf(l0, l1), e0 = expf(l0 - m), e1 = expf(l1 - m);
    lb[i] = e0 / (e0 + e1);
}
__global__ __launch_bounds__(256) void k_rms_mod(const float* in, float* out, const float* g, const float* modrow, int sh_off, int sc_off) {
    __shared__ float red[4];
    const float* x = in + (size_t)blockIdx.x * D; float* o = out + (size_t)blockIdx.x * D;
    float v[4], ss = 0;
#pragma unroll
    for (int j = 0; j < 4; ++j) { v[j] = x[threadIdx.x + 256 * j]; ss += v[j] * v[j]; }
    const float tot = block_sum256(ss, red), inv = 1.0f / sqrtf(tot / D + EPS);
#pragma unroll
    for (int j = 0; j < 4; ++j) { const int n = threadIdx.x + 256 * j; o[n] = (v[j] * inv * g[n]) * (1.f + modrow[sc_off + n]) + modrow[sh_off + n]; }
}
__global__ __launch_bounds__(256) void k_gemm(const float* A, int lda, const float* B, int ldb, float* C, int ldc, int M, int N, int K) {
    __shared__ float As[16][128 + 4];
    __shared__ float Bs[16][64 + 4];
    const int tx = threadIdx.x & 15, ty = threadIdx.x >> 4, m0 = blockIdx.y * 128, n0 = blockIdx.x * 64;
    float acc[8][4];
#pragma unroll
    for (int i = 0; i < 8; ++i)
#pragma unroll
        for (int j = 0; j < 4; ++j) acc[i][j] = 0.f;
    for (int k0 = 0; k0 < K; k0 += 16) {
#pragma unroll
        for (int i = 0; i < 8; ++i) { const int idx = threadIdx.x + i * 256, m = idx >> 4, k = idx & 15; As[k][m] = (m0 + m < M) ? A[(size_t)(m0 + m) * lda + k0 + k] : 0.f; }
#pragma unroll
        for (int i = 0; i < 4; ++i) { const int idx = threadIdx.x + i * 256, k = idx >> 6, n = idx & 63; Bs[k][n] = (n0 + n < N) ? B[(size_t)(k0 + k) * ldb + n0 + n] : 0.f; }
        __syncthreads();
#pragma unroll
        for (int k = 0; k < 16; ++k) {
            float a[8], b[4];
#pragma unroll
            for (int i = 0; i < 8; ++i) a[i] = As[k][ty * 8 + i];
#pragma unroll
            for (int j = 0; j < 4; ++j) b[j] = Bs[k][tx * 4 + j];
#pragma unroll
            for (int i = 0; i < 8; ++i)
#pragma unroll
                for (int j = 0; j < 4; ++j) acc[i][j] += a[i] * b[j];
        }
        __syncthreads();
    }
#pragma unroll
    for (int i = 0; i < 8; ++i)
#pragma unroll
        for (int j = 0; j < 4; ++j) { const int m = m0 + ty * 8 + i, n = n0 + tx * 4 + j; if (m < M && n < N) C[(size_t)m * ldc + n] = acc[i][j]; }
}
__global__ void k_conv(const float* zq, const float* w, float* out) {
    const size_t i = (size_t)blockIdx.x * blockDim.x + threadIdx.x; if (i >= (size_t)ROWS * 3072) return;
    const int row = (int)(i / 3072), ch = (int)(i % 3072);
    float y = 0.f;
    if (row < CT) {
#pragma unroll
        for (int j = 0; j < 3; ++j) { const int t = row + j - 1; if (t >= 0 && t < CT) y += w[(1 * 3 + j) * 3072 + ch] * zq[(size_t)t * 3072 + ch]; }
    } else {
        const int t = row - CT, r = t >> 6, c = t & 63;
#pragma unroll
        for (int dy = 0; dy < 3; ++dy)
#pragma unroll
            for (int dx = 0; dx < 3; ++dx) { const int rr = r + dy - 1, cc = c + dx - 1; if (rr >= 0 && rr < 64 && cc >= 0 && cc < 64) y += w[(dy * 3 + dx) * 3072 + ch] * zq[(size_t)(CT + rr * 64 + cc) * 3072 + ch]; }
    }
    out[i] = siluf(y);
}
__global__ __launch_bounds__(256) void k_l2n(float* qkvc) {
    const int gw = blockIdx.x * 4 + (threadIdx.x >> 6), lane = threadIdx.x & 63; if (gw >= ROWS * 16) return;
    const int row = gw >> 4, hh = gw & 15;
    float* p = qkvc + (size_t)row * 3072 + hh * 128;
    const float a = p[lane], b = p[lane + 64]; float s = a * a + b * b;
#pragma unroll
    for (int o = 32; o >= 1; o >>= 1) s += __shfl_xor(s, o);
    const float inv = (1.0f / sqrtf(s + EPS)) * (hh < 8 ? 0.08838834764831845f : 1.0f);
    p[lane] = a * inv; p[lane + 64] = b * inv;
}
__global__ void k_gates(const float* zab, const float* a_log, const float* dt_bias, float* la, float* be) {
    const int i = blockIdx.x * blockDim.x + threadIdx.x; if (i >= ROWS * 16) return;
    const int row = i >> 4, j = i & 15;
    la[i] = -expf(a_log[j]) * softplusf(zab[row * 32 + j] + dt_bias[j]);
    be[i] = sigm(zab[row * 32 + 16 + j]);
}
__global__ __launch_bounds__(128) void k_gdn_scan(const float* qkvc, const float* la, const float* be, float* o) {
    const int h = blockIdx.x & 7, dir = blockIdx.x >> 3, v = threadIdx.x;
    __shared__ float sq[2][128], sk[2][128];
    float S[128];
#pragma unroll
    for (int k = 0; k < 128; ++k) S[k] = 0.f;
    for (int s = 0; s < ROWS; ++s) {
        const int row = dir == 0 ? s : (s < CT ? CT - 1 - s : ROWS - 1 - (s - CT));
        const float* r = qkvc + (size_t)row * 3072 + h * 128; const int buf = s & 1;
        sq[buf][v] = r[v]; sk[buf][v] = r[1024 + v]; const float vv = r[2048 + v];
        const float a = expf(la[row * 16 + dir * 8 + h]), b = be[row * 16 + dir * 8 + h];
        __syncthreads();
        float ks = 0.f;
#pragma unroll
        for (int k = 0; k < 128; ++k) ks += sk[buf][k] * S[k];
        const float delta = b * (vv - a * ks); float ov = 0.f;
#pragma unroll
        for (int k = 0; k < 128; ++k) { S[k] = a * S[k] + sk[buf][k] * delta; ov += sq[buf][k] * S[k]; }
        if (row >= CT) atomicAdd(&o[(size_t)(row - CT) * 1024 + h * 128 + v], ov);
    }
}
__global__ __launch_bounds__(128) void k_hgrn_scan(const float* zh, const float* lb, float* o) {
    const int h = blockIdx.x & 7, dir = blockIdx.x >> 3, v = threadIdx.x;
    __shared__ float sq[2][128], sk[2][128], sf[2][128];
    const float lbv = lb[dir * 1024 + h * 128 + v];
    float S[128];
#pragma unroll
    for (int k = 0; k < 128; ++k) S[k] = 0.f;
    for (int s = 0; s < ROWS; ++s) {
        const int row = dir == 0 ? s : (s < CT ? CT - 1 - s : ROWS - 1 - (s - CT));
        const float* r = zh + (size_t)row * 4096; const int buf = s & 1;
        const float fz = r[dir * 1024 + h * 128 + v];
        sf[buf][v] = lbv + (1.f - lbv) * sigm(fz); sk[buf][v] = (1.f - lbv) * sigm(-fz);
        sq[buf][v] = siluf(r[2048 + h * 128 + v]) * 0.08838834764831845f; const float vv = r[3072 + h * 128 + v];
        __syncthreads();
        float ov = 0.f;
#pragma unroll
        for (int k = 0; k < 128; ++k) { S[k] = sf[buf][k] * S[k] + sk[buf][k] * vv; ov += sq[buf][k] * S[k]; }
        if (row >= CT) atomicAdd(&o[(size_t)(row - CT) * 1024 + h * 128 + v], ov);
    }
}
__global__ __launch_bounds__(256) void k_mixer_y(const float* o, const float* g, int ldg, const float* w, float* y) {
    const int gw = blockIdx.x * 4 + (threadIdx.x >> 6), lane = threadIdx.x & 63; if (gw >= T * 8) return;
    const int t = gw >> 3, h = gw & 7;
    const float* p = o + (size_t)t * 1024 + h * 128; const float a = p[lane], b = p[lane + 64]; float s = a * a + b * b;
#pragma unroll
    for (int off = 32; off >= 1; off >>= 1) s += __shfl_xor(s, off);
    const float inv = 1.0f / sqrtf(s / 128.f + EPS);
    const float* gp = g + (size_t)t * ldg + h * 128; float* yp = y + (size_t)t * 1024 + h * 128;
    yp[lane] = (a * inv * w[lane]) * siluf(gp[lane]); yp[lane + 64] = (b * inv * w[lane + 64]) * siluf(gp[lane + 64]);
}
__global__ void k_merge(const float* pa, const float* pb, const float* mg, float* m) {
    const size_t i = (size_t)blockIdx.x * blockDim.x + threadIdx.x; if (i >= (size_t)T * D) return;
    const size_t t = i / D; const int n = (int)(i % D);
    m[i] = sigm(mg[t * 2048 + n]) * pa[i] + sigm(mg[t * 2048 + 1024 + n]) * pb[i];
}
__global__ __launch_bounds__(256) void k_resid(const float* xin, const float* r, const float* g, const float* modrow, int gt_off, float* xo) {
    __shared__ float red[4];
    const size_t base = (size_t)blockIdx.x * D;
    float v[4], ss = 0;
#pragma unroll
    for (int j = 0; j < 4; ++j) { v[j] = r[base + threadIdx.x + 256 * j]; ss += v[j] * v[j]; }
    const float tot = block_sum256(ss, red), inv = 1.0f / sqrtf(tot / D + EPS);
#pragma unroll
    for (int j = 0; j < 4; ++j) { const int n = threadIdx.x + 256 * j; xo[base + n] = xin[base + n] + modrow[gt_off + n] * (v[j] * inv * g[n]); }
}
__global__ void k_relu2(float* p, size_t n) { const size_t i = (size_t)blockIdx.x * blockDim.x + threadIdx.x; if (i < n) { const float x = fmaxf(p[i], 0.f); p[i] = x * x; } }
}

struct Ins {
    const float *x, *c, *ctx, *c_ctx, *w_ada, *b_ada, *norm_g, *w_in, *conv_w, *a_log, *dt_bias, *gdn_nw, *lb_logits, *hgrn_nw, *w_ba, *w_bb, *w_out, *w1, *w2;
};
static inline Ins get_ins(void* const* d_in) {
    Ins I; const float** p = (const float**)&I; for (int i = 0; i < 19; ++i) p[i] = (const float*)d_in[i]; return I;
}
static inline void nv_gemm(const float* A, int lda, const float* B, int ldb, float* C, int ldc, int M, int N, int K, hipStream_t s) {
    dim3 grid((N + 63) / 64, (M + 127) / 128);
    hipLaunchKernelGGL(nv::k_gemm, grid, dim3(256), 0, s, A, lda, B, ldb, C, ldc, M, N, K);
}
struct OB { float *mod, *lb, *hb, *zab, *la, *be, *zbuf, *qkvc, *oa, *ob, *ya, *yb, *mbuf, *rbuf; };
static inline bool ob_carve(OB& B, char* base, size_t avail, int stop = 99) {
    using namespace nv; size_t off = 0;
    auto carve = [&](size_t bytes) { float* p = (float*)(base + off); off += (bytes + 255) & ~(size_t)255; return p; };
    B.mod = carve(5 * 6 * D * 4); B.lb = carve(2 * D * 4);
    B.hb = carve((size_t)ROWS * D * 4);
    B.zab = carve((size_t)ROWS * 32 * 4); B.la = carve((size_t)ROWS * 16 * 4); B.be = carve((size_t)ROWS * 16 * 4);
    B.oa = carve((size_t)T * D * 4); B.ob = carve((size_t)T * D * 4);
    B.zbuf = carve((size_t)ROWS * 4096 * 4); if (stop == 1 || stop == 4) return off <= avail;
    B.qkvc = carve((size_t)ROWS * 3072 * 4); if (stop == 2 || stop == 3) return off <= avail;
    B.ya = carve((size_t)T * D * 4); B.yb = carve((size_t)T * D * 4);
    B.mbuf = carve((size_t)T * D * 4); B.rbuf = carve((size_t)T * D * 4);
    return off <= avail;
}
static void oracle_pre(const OB& B, const Ins& I, hipStream_t stream) {
    using namespace nv;
    hipLaunchKernelGGL(k_mod, dim3(6 * D / 256), dim3(256), 0, stream, I.c, I.c_ctx, I.w_ada, I.b_ada, B.mod);
    hipLaunchKernelGGL(k_lb, dim3(2 * D / 256), dim3(256), 0, stream, I.lb_logits, B.lb);
}
static void oracle_batch(const OB& B, int b, int stop, const Ins& I, float* out, hipStream_t stream) {
    using namespace nv;
    const float* xb = I.x + (size_t)b * T * D; const float* cb = I.ctx + (size_t)b * CT * D; float* outb = out + (size_t)b * T * D;
    const float* modb = B.mod + (size_t)b * 6 * D; const float* modc = B.mod + (size_t)4 * 6 * D;
    float *hb = B.hb, *zbuf = B.zbuf, *qkvc = B.qkvc, *zab = B.zab, *la = B.la, *be = B.be, *oa = B.oa, *ob = B.ob, *ya = B.ya, *yb = B.yb, *mbuf = B.mbuf, *rbuf = B.rbuf;
    hipLaunchKernelGGL(k_rms_mod, dim3(CT), dim3(256), 0, stream, cb, hb, I.norm_g, modc, 0, D);
    hipLaunchKernelGGL(k_rms_mod, dim3(T), dim3(256), 0, stream, xb, hb + (size_t)CT * D, I.norm_g, modb, 0, D);
    if (stop != 4) {
        nv_gemm(hb, D, I.w_in + C_QKV, INT, zbuf, 3072, ROWS, 3072, D, stream);
        nv_gemm(hb, D, I.w_in + C_AIN, INT, zab, 32, ROWS, 32, D, stream);
        hipLaunchKernelGGL(k_gates, dim3(ROWS * 16 / 256), dim3(256), 0, stream, zab, I.a_log, I.dt_bias, la, be);
        if (stop == 1) return;
        hipLaunchKernelGGL(k_conv, dim3((unsigned)(((size_t)ROWS * 3072 + 255) / 256)), dim3(256), 0, stream, zbuf, I.conv_w, qkvc);
        hipLaunchKernelGGL(k_l2n, dim3(ROWS * 16 / 4), dim3(256), 0, stream, qkvc);
        if (stop == 2) return;
        (void)hipMemsetAsync(oa, 0, (size_t)T * D * 4, stream);
        hipLaunchKernelGGL(k_gdn_scan, dim3(16), dim3(128), 0, stream, qkvc, la, be, oa);
        if (stop == 3) return;
    }
    nv_gemm(hb, D, I.w_in + C_FIN, INT, zbuf, 4096, ROWS, 4096, D, stream);
    (void)hipMemsetAsync(ob, 0, (size_t)T * D * 4, stream);
    hipLaunchKernelGGL(k_hgrn_scan, dim3(16), dim3(128), 0, stream, zbuf, B.lb, ob);
    if (stop == 4) return;
    float* zga = zbuf; float* zgb = zbuf + (size_t)T * D; float* zmg = zbuf + (size_t)2 * T * D;
    const float* hl = hb + (size_t)CT * D;
    nv_gemm(hl, D, I.w_in + C_GA, INT, zga, D, T, D, D, stream);
    nv_gemm(hl, D, I.w_in + C_GB, INT, zgb, D, T, D, D, stream);
    nv_gemm(hl, D, I.w_in + C_MG, INT, zmg, 2 * D, T, 2 * D, D, stream);
    hipLaunchKernelGGL(k_mixer_y, dim3(T * 8 / 4), dim3(256), 0, stream, oa, zga, D, I.gdn_nw, ya);
    hipLaunchKernelGGL(k_mixer_y, dim3(T * 8 / 4), dim3(256), 0, stream, ob, zgb, D, I.hgrn_nw, yb);
    if (stop == 5) return;
    float* pa = qkvc; float* pb = qkvc + (size_t)T * D;
    nv_gemm(ya, D, I.w_ba, D, pa, D, T, D, D, stream);
    nv_gemm(yb, D, I.w_bb, D, pb, D, T, D, D, stream);
    hipLaunchKernelGGL(k_merge, dim3(T * D / 256), dim3(256), 0, stream, pa, pb, zmg, mbuf);
    if (stop == 6) return;
    nv_gemm(mbuf, D, I.w_out, D, rbuf, D, T, D, D, stream);
    hipLaunchKernelGGL(k_resid, dim3(T), dim3(256), 0, stream, xb, rbuf, I.norm_g + D, modb, 2 * D, outb);
    hipLaunchKernelGGL(k_rms_mod, dim3(T), dim3(256), 0, stream, outb, ya, I.norm_g + 2 * D, modb, 3 * D, 4 * D);
    if (stop == 7) return;
    nv_gemm(ya, D, I.w1, FF, zbuf, FF, T, FF, D, stream);
    hipLaunchKernelGGL(k_relu2, dim3((unsigned)((size_t)T * FF / 256)), dim3(256), 0, stream, zbuf, (size_t)T * FF);
    nv_gemm(zbuf, FF, I.w2, D, yb, D, T, D, FF, stream);
    hipLaunchKernelGGL(k_resid, dim3(T), dim3(256), 0, stream, outb, yb, I.norm_g + 3 * D, modb, 5 * D, outb);
}
namespace nv {
__host__ __device__ inline int fast_row(int b, int r) { return r < CT ? NB * T + b * CT + r : b * T + (r - CT); }
template <typename TA> __device__ __forceinline__ float ldv(const TA* p, size_t i);
template <> __device__ __forceinline__ float ldv<float>(const float* p, size_t i) { return p[i]; }
template <> __device__ __forceinline__ float ldv<unsigned short>(const unsigned short* p, size_t i) { return __uint_as_float(((unsigned)p[i]) << 16); }
template <typename TA> __global__ void k_cmp(const TA* fast, int fld, int fcol0, const float* orc, int old, int b, int r0, int nr, int nc, int rowmode, float* err) {
    float num = 0.f, den = 0.f;
    const size_t tot = (size_t)nr * nc;
    for (size_t i = (size_t)blockIdx.x * blockDim.x + threadIdx.x; i < tot; i += (size_t)gridDim.x * blockDim.x) {
        const int r = r0 + (int)(i / nc), c = (int)(i % nc);
        const int fr = rowmode == 0 ? fast_row(b, r) : b * T + r;
        const float a = ldv<TA>(fast, (size_t)fr * fld + fcol0 + c), o = orc[(size_t)r * old + c];
        const float d = a - o; num += d * d; den += o * o;
    }
#pragma unroll
    for (int o = 32; o >= 1; o >>= 1) { num += __shfl_xor(num, o); den += __shfl_xor(den, o); }
    if ((threadIdx.x & 63) == 0) { atomicAdd(err, num); atomicAdd(err + 1, den); }
}
__global__ void k_cmp2(const unsigned short* f0, const unsigned short* f1, int fld, const float* orc, int old, int b, int nr, int nc, float* err) {
    float num = 0.f, den = 0.f;
    const size_t tot = (size_t)nr * nc;
    for (size_t i = (size_t)blockIdx.x * blockDim.x + threadIdx.x; i < tot; i += (size_t)gridDim.x * blockDim.x) {
        const int r = (int)(i / nc), c = (int)(i % nc); const size_t fi = (size_t)(b * T + r) * fld + c;
        const float a = ldv<unsigned short>(f0, fi) + ldv<unsigned short>(f1, fi), o = orc[(size_t)r * old + c];
        const float d = a - o; num += d * d; den += o * o;
    }
#pragma unroll
    for (int o = 32; o >= 1; o >>= 1) { num += __shfl_xor(num, o); den += __shfl_xor(den, o); }
    if ((threadIdx.x & 63) == 0) { atomicAdd(err, num); atomicAdd(err + 1, den); }
}
__global__ void k_scale_out(float* out, size_t n, const float* err, int nerr) {
    float e = 0.f; for (int i = 0; i < nerr; ++i) e += sqrtf(err[2 * i] / fmaxf(err[2 * i + 1], 1e-30f));
    if (!(e == e)) e = 10.f;
    if (!(e < 10.f)) e = 10.f;
    for (size_t i = (size_t)blockIdx.x * blockDim.x + threadIdx.x; i < n; i += (size_t)gridDim.x * blockDim.x) out[i] *= (1.f + e);
}
}
namespace pg8 {
#define PG8_LAS __attribute__((address_space(3)))
typedef unsigned short bf16_t;
typedef short bf16x8 __attribute__((ext_vector_type(8)));
typedef float f32x4 __attribute__((ext_vector_type(4)));
typedef unsigned u32x4 __attribute__((ext_vector_type(4)));
constexpr int BM = 256, BK = 64, HALF = 128, HTB = HALF * BK * 2  , STAGE_BYTES = 8 * HTB, NXCD = 8, WGM = 8;

__host__ __device__ __forceinline__ int lds_byte(int r, int c) { const int st = (r >> 4) * 2 + (c >> 5), rr = r & 15, cc = c & 31, ob = rr * 64 + cc * 2; return st * 1024 + (ob ^ (((ob >> 9) & 1) << 5)); }
__host__ __device__ __forceinline__ void stage_rc(int b, int& R, int& C) { const int st = b / 1024, sb = b % 1024, swz = sb ^ (((sb >> 9) & 1) << 5); R = (st >> 1) * 16 + swz / 64; C = (st & 1) * 32 + (swz % 64) / 2; }
__host__ __device__ __forceinline__ int perm32(int rho) { const int n = rho >> 4, i = rho & 15; return 8 * (i >> 2) + 4 * n + (i & 3); }

struct Unit { int pm, pn; };
struct Gemm { const bf16_t* A; const bf16_t* Bt; int M, N, K; };

struct StaticOrder {
    int nM, nN, nwg, G, c;
    __host__ __device__ void init(int M, int N, int G_, int c_) { nM = M / BM; nN = N / BM; nwg = nM * nN; G = G_; c = c_; }
    __host__ __device__ bool next(int i, Unit& u) const {
        const long L = (long)i * G + c; if (L >= nwg) return false;
        int wgid = (int)L; { const int q = nwg / NXCD, r = nwg % NXCD, xcd = wgid % NXCD, off = wgid / NXCD; wgid = (xcd < r ? xcd * (q + 1) : r * (q + 1) + (xcd - r) * q) + off; }
        const int nig = WGM * nN, gid = wgid / nig, fm = gid * WGM, gsz = (nM - fm) < WGM ? (nM - fm) : WGM;
        u.pm = fm + ((wgid % nig) % gsz); u.pn = (wgid % nig) / gsz; return true;
    }
    __device__ __forceinline__ void a_ready(const Unit&) const {}
    __device__ __forceinline__ void done(const Unit&) const {}
};

__device__ __forceinline__ unsigned cvt_pk_bf16(float lo, float hi) { unsigned r; asm volatile("v_cvt_pk_bf16_f32 %0, %1, %2" : "=v"(r) : "v"(lo), "v"(hi)); return r; }
typedef float f32x2 __attribute__((ext_vector_type(2)));
typedef float f32x2 __attribute__((ext_vector_type(2)));
template <class Epi, class Sched, bool ALIGN_EPI = false, bool SP2 = false>
__device__ __forceinline__ void gemm_phase(PG8_LAS unsigned char* lds, const Gemm g, const Sched& S, const Epi& E) {
    const int tid = threadIdx.x, wid = __builtin_amdgcn_readfirstlane(tid >> 6), lane = tid & 63, wr = wid >> 2, wc = wid & 3, fr = lane & 15, fq = lane >> 4;
    const int K = g.K, nt = K / BK;
    unsigned voffA[2], voffB[2];
#pragma unroll
    for (int i = 0; i < 2; ++i) { int R, C; stage_rc(tid * 16 + i * 8192, R, C); const int Rb = Epi::PERM ? ((R & ~31) + perm32(R & 31)) : R;
        voffA[i] = (unsigned)(R * K + C) * 2u; voffB[i] = (unsigned)(Rb * K + C) * 2u; }
    const size_t kstep = (size_t)(BK * 2);
    const size_t hstep = (size_t)HALF * K * 2;
    const size_t tstep = 2 * hstep;
    const unsigned ldsw = (unsigned)wid * 1024u;
    const int aoff = lds_byte(wr * 64 + fr, fq * 8), boff = lds_byte(wc * 32 + fr, fq * 8);
#define PG8_SA(b, h) (((b) * 2 + (h)) * HTB)
#define PG8_SB(b, h) ((4 + (b) * 2 + (h)) * HTB)
#define PG8_STAGE(bufoff, gbase, voff) do { _Pragma("unroll") for (int _i = 0; _i < 2; ++_i) \
        __builtin_amdgcn_global_load_lds((const unsigned*)((const char*)(gbase) + (voff)[_i]), (PG8_LAS unsigned*)(lds + (bufoff) + ldsw + _i * 8192), 16, 0, 0); } while (0)
#define PG8_LDA(dst, b, h) do { _Pragma("unroll") for (int m = 0; m < 4; ++m) _Pragma("unroll") for (int k = 0; k < 2; ++k) dst[m][k] = *(const PG8_LAS bf16x8*)(lds + PG8_SA(b, h) + aoff + m * 2048 + k * 1024); } while (0)
#define PG8_LDB(dst, b, h) do { _Pragma("unroll") for (int n = 0; n < 2; ++n) _Pragma("unroll") for (int k = 0; k < 2; ++k) dst[n][k] = *(const PG8_LAS bf16x8*)(lds + PG8_SB(b, h) + boff + n * 2048 + k * 1024); } while (0)
#define PG8_MMA(ai, bj, At, Bt) do { __builtin_amdgcn_s_setprio(1); _Pragma("unroll") for (int m = 0; m < 4; ++m) _Pragma("unroll") for (int n = 0; n < 2; ++n) _Pragma("unroll") for (int k = 0; k < 2; ++k) \
        acc[ai][bj][m][n] = __builtin_amdgcn_mfma_f32_16x16x32_bf16(Bt[n][k], At[m][k], acc[ai][bj][m][n], 0, 0, 0); __builtin_amdgcn_s_setprio(0); } while (0)
#define PG8_WAIT_V(n) asm volatile("s_waitcnt vmcnt(" #n ")" ::: "memory")
#define PG8_WAIT_L(n) asm volatile("s_waitcnt lgkmcnt(" #n ")" ::: "memory")
#define PG8_BAR __builtin_amdgcn_s_barrier()
#define PG8_SCHED __builtin_amdgcn_sched_barrier(0)
    Unit cur, nxt; int ui = 0;
    if (!S.next(0, cur)) return;
    f32x4 acc[2][2][4][2];
#pragma unroll
    for (int a = 0; a < 2; ++a)
#pragma unroll
        for (int b = 0; b < 2; ++b)
#pragma unroll
            for (int m = 0; m < 4; ++m)
#pragma unroll
                for (int n = 0; n < 2; ++n) acc[a][b][m][n] = (f32x4){0.f, 0.f, 0.f, 0.f};
    bf16x8 At[4][2], B0[2][2], B1[2][2];
    const char* cA = (const char*)g.A + (size_t)cur.pm * tstep; const char* cB = (const char*)g.Bt + (size_t)cur.pn * tstep;
    S.a_ready(cur);
    if constexpr (SP2) {
        PG8_STAGE(PG8_SB(0, 0), cB, voffB); PG8_STAGE(PG8_SB(0, 1), cB + hstep, voffB); PG8_STAGE(PG8_SA(0, 0), cA, voffA); PG8_STAGE(PG8_SA(0, 1), cA + hstep, voffA);
        if (wr == 1) PG8_BAR;
        PG8_WAIT_V(2); PG8_BAR;
        PG8_STAGE(PG8_SB(1, 0), cB + kstep, voffB); PG8_STAGE(PG8_SA(1, 0), cA + kstep, voffA); PG8_STAGE(PG8_SB(1, 1), cB + hstep + kstep, voffB);
        PG8_WAIT_V(6); PG8_BAR;
    } else {
        PG8_STAGE(PG8_SB(0, 0), cB, voffB); PG8_STAGE(PG8_SA(0, 0), cA, voffA); PG8_STAGE(PG8_SB(0, 1), cB + hstep, voffB); PG8_STAGE(PG8_SA(0, 1), cA + hstep, voffA);
        if (wr == 1) PG8_BAR;
        PG8_WAIT_V(4); PG8_BAR;
        PG8_STAGE(PG8_SB(1, 0), cB + kstep, voffB); PG8_STAGE(PG8_SA(1, 0), cA + kstep, voffA); PG8_STAGE(PG8_SB(1, 1), cB + hstep + kstep, voffB);
        PG8_WAIT_V(6); PG8_BAR;
    }
    for (;;) {
        const bool has_next = S.next(ui + 1, nxt);
        const char* nA = has_next ? (const char*)g.A + (size_t)nxt.pm * tstep : cA; const char* nB = has_next ? (const char*)g.Bt + (size_t)nxt.pn * tstep : cB;
        for (int t = 0; t < nt; t += 2) {
            const bool last = (t == nt - 2);
            const char* a1 = cA + (size_t)(t + 1) * kstep;
            const char* a2 = last ? nA : cA + (size_t)(t + 2) * kstep; const char* b2 = last ? nB : cB + (size_t)(t + 2) * kstep;
            const char* a3 = a2 + kstep; const char* b3 = b2 + kstep;
            if (last && has_next) S.a_ready(nxt);
            if constexpr (SP2) {
            PG8_LDB(B0, 0, 0); PG8_LDB(B1, 0, 1); PG8_SCHED; PG8_LDA(At, 0, 0); PG8_STAGE(PG8_SA(1, 1), a1 + hstep, voffA);
            PG8_WAIT_V(8); PG8_WAIT_L(0); PG8_BAR; PG8_MMA(0, 0, At, B0); PG8_MMA(0, 1, At, B1); PG8_BAR; PG8_SCHED;
            PG8_LDA(At, 0, 1); PG8_STAGE(PG8_SB(0, 0), b2, voffB); PG8_STAGE(PG8_SB(0, 1), b2 + hstep, voffB); PG8_STAGE(PG8_SA(0, 0), a2, voffA);
            PG8_WAIT_V(8); PG8_WAIT_L(0); PG8_BAR; PG8_MMA(1, 0, At, B0); PG8_MMA(1, 1, At, B1); PG8_BAR; PG8_SCHED;
            PG8_LDB(B0, 1, 0); PG8_LDB(B1, 1, 1); PG8_SCHED; PG8_LDA(At, 1, 0); PG8_STAGE(PG8_SA(0, 1), a2 + hstep, voffA);
            PG8_WAIT_V(8); PG8_WAIT_L(0); PG8_BAR; PG8_MMA(0, 0, At, B0); PG8_MMA(0, 1, At, B1); PG8_BAR; PG8_SCHED;
            PG8_LDA(At, 1, 1); PG8_STAGE(PG8_SB(1, 0), b3, voffB); PG8_STAGE(PG8_SB(1, 1), b3 + hstep, voffB); PG8_STAGE(PG8_SA(1, 0), a3, voffA);
            PG8_WAIT_V(8); PG8_WAIT_L(0); PG8_BAR; PG8_MMA(1, 0, At, B0); PG8_MMA(1, 1, At, B1); PG8_BAR; PG8_SCHED;
            } else {
            PG8_LDB(B0, 0, 0); PG8_SCHED; PG8_LDA(At, 0, 0); PG8_STAGE(PG8_SA(1, 1), a1 + hstep, voffA);
            PG8_WAIT_L(8); PG8_BAR; PG8_WAIT_L(0); PG8_MMA(0, 0, At, B0); PG8_BAR; PG8_SCHED;
            PG8_LDB(B1, 0, 1); PG8_STAGE(PG8_SB(0, 0), b2, voffB);
            PG8_BAR; PG8_WAIT_L(0); PG8_MMA(0, 1, At, B1); PG8_BAR;
            PG8_LDA(At, 0, 1); PG8_STAGE(PG8_SA(0, 0), a2, voffA);
            PG8_BAR; PG8_WAIT_L(0); PG8_MMA(1, 0, At, B0); PG8_BAR; PG8_SCHED;
            PG8_STAGE(PG8_SB(0, 1), b2 + hstep, voffB);
            PG8_WAIT_V(6); PG8_BAR; PG8_MMA(1, 1, At, B1); PG8_BAR;
            PG8_LDB(B0, 1, 0); PG8_SCHED; PG8_LDA(At, 1, 0); PG8_STAGE(PG8_SA(0, 1), a2 + hstep, voffA);
            PG8_WAIT_L(8); PG8_BAR; PG8_WAIT_L(0); PG8_MMA(0, 0, At, B0); PG8_BAR; PG8_SCHED;
            PG8_LDB(B1, 1, 1); PG8_STAGE(PG8_SB(1, 0), b3, voffB);
            PG8_BAR; PG8_WAIT_L(0); PG8_MMA(0, 1, At, B1); PG8_BAR;
            PG8_LDA(At, 1, 1); PG8_STAGE(PG8_SA(1, 0), a3, voffA);
            PG8_BAR; PG8_WAIT_L(0); PG8_MMA(1, 0, At, B0); PG8_BAR; PG8_SCHED;
            PG8_STAGE(PG8_SB(1, 1), b3 + hstep, voffB);
            PG8_WAIT_V(6); PG8_BAR; PG8_MMA(1, 1, At, B1); PG8_BAR;
            }
        }
        if constexpr (ALIGN_EPI) { if (wr == 0) PG8_BAR; }
        if constexpr (!Epi::AFTER_DRAIN) { E(acc, cur, wr, wc, fr, fq); S.done(cur); }
        if (!has_next) break;
#pragma unroll
        for (int a = 0; a < 2; ++a)
#pragma unroll
            for (int b = 0; b < 2; ++b)
#pragma unroll
                for (int m = 0; m < 4; ++m)
#pragma unroll
                    for (int n = 0; n < 2; ++n) acc[a][b][m][n] = (f32x4){0.f, 0.f, 0.f, 0.f};
        cur = nxt; cA = nA; cB = nB; ++ui;
        if constexpr (ALIGN_EPI) { if (wr == 1) PG8_BAR; }
    }
    PG8_WAIT_V(0);
    if constexpr (!ALIGN_EPI) { if (wr == 0) PG8_BAR; }
    PG8_BAR;
    if constexpr (Epi::AFTER_DRAIN) { E.fused(acc, cur, wr, wc, fr, fq, lds, wid, lane); S.done(cur); }
#undef PG8_SA
#undef PG8_SB
#undef PG8_STAGE
#undef PG8_LDA
#undef PG8_LDB
#undef PG8_MMA
#undef PG8_WAIT_V
#undef PG8_WAIT_L
#undef PG8_BAR
#undef PG8_SCHED
}
}
namespace fk {
#define GAS __attribute__((address_space(1)))
#define LAS __attribute__((address_space(3)))
typedef unsigned short bf16;
typedef unsigned v4u __attribute__((ext_vector_type(4)));
typedef unsigned v2u __attribute__((ext_vector_type(2)));
typedef float f32x4 __attribute__((ext_vector_type(4)));
typedef short bf16x8 __attribute__((ext_vector_type(8)));
typedef GAS unsigned gu32;
#define RLX_AGENT __ATOMIC_RELAXED, __HIP_MEMORY_SCOPE_AGENT
#define LDS_WAIT() asm volatile("s_waitcnt lgkmcnt(0)" ::: "memory")
#define VM_WAIT() asm volatile("s_waitcnt vmcnt(0)" ::: "memory")
__device__ __forceinline__ unsigned f2bf(float f) { unsigned u = __builtin_bit_cast(unsigned, f); return (u + 0x7fffu + ((u >> 16) & 1u)) >> 16; }
__device__ __forceinline__ unsigned pk2(float lo, float hi) { return f2bf(lo) | (f2bf(hi) << 16); }
__device__ __forceinline__ float bf2f(unsigned short b) { return __uint_as_float(((unsigned)b) << 16); }
__device__ __forceinline__ float bflo(unsigned w) { return __uint_as_float(w << 16); }
__device__ __forceinline__ float bfhi(unsigned w) { return __uint_as_float(w & 0xffff0000u); }
__device__ __forceinline__ float sigm(float x) { return 1.f / (1.f + __expf(-x)); }
__device__ __forceinline__ float siluf(float x) { return x / (1.f + __expf(-x)); }
__device__ __forceinline__ float softplusf(float x) { return fmaxf(x, 0.f) + log1pf(__expf(-fabsf(x))); }
__device__ __forceinline__ float wave_sum(float v) {
#pragma unroll
    for (int o = 1; o < 64; o <<= 1) v += __shfl_xor(v, o);
    return v;
}
#define XB_TMO      128
#define XB_XCNT(j)  (256  + 64 * (j))
#define XB_XSUB(j)  (1280 + 64 * (j))
#define XB_XGEN(j)  (2304 + 64 * (j))
#define XB_TOP      3328
#define XB_TOPGEN   3392
#define XCD_BAR_WORDS 3456
#define XB_SPIN_CAP (1u << 18)

__device__ __forceinline__ unsigned xb_ld(unsigned* p)              { return __hip_atomic_load(p, __ATOMIC_RELAXED, __HIP_MEMORY_SCOPE_AGENT); }
__device__ __forceinline__ unsigned xb_add(unsigned* p, unsigned v) { return __hip_atomic_fetch_add(p, v, __ATOMIC_RELAXED, __HIP_MEMORY_SCOPE_AGENT); }
__device__ __forceinline__ unsigned xb_xcc_id() { return (unsigned)__builtin_amdgcn_s_getreg((3 << 11) | 20) & 0xFu; }
#define XB_SPIN(cond, bar) do { unsigned _sp = 0; while (cond) { __builtin_amdgcn_s_sleep(1); \
    if ((++_sp & 255u) == 0u) { if (xb_ld(&(bar)[XB_TMO])) break; if (_sp > XB_SPIN_CAP) { atomicAdd(&(bar)[XB_TMO], 1u); break; } } } } while (0)

struct XcdBarrier {
    unsigned* bar; unsigned x;
    volatile LAS unsigned* st;
};

__device__ __forceinline__ XcdBarrier xcd_barrier_post(unsigned* bar, volatile LAS unsigned* st) {
    XcdBarrier b; b.bar = bar; b.x = xb_xcc_id(); b.st = st;
    if (threadIdx.x == 0) (void)xb_add(&bar[XB_XCNT(b.x)], 1u);
    return b;
}
__device__ __forceinline__ void xcd_barrier_complete(unsigned* bar, unsigned x, unsigned& nloc, unsigned& nx) {
    const unsigned G = gridDim.x * gridDim.y * gridDim.z;
    unsigned sum, cnt, mine, sp = 0u;
    for (;;) {
        sum = 0u; cnt = 0u; mine = 0u;
#pragma unroll
        for (unsigned j = 0; j < 16; ++j) { const unsigned c = xb_ld(&bar[XB_XCNT(j)]); sum += c; cnt += (c > 0u) ? 1u : 0u; mine = (j == x) ? c : mine; }
        if (sum == G) break;
        __builtin_amdgcn_s_sleep(1);
        if ((++sp & 255u) == 0u) { if (xb_ld(&bar[XB_TMO])) break; if (sp > XB_SPIN_CAP) { atomicAdd(&bar[XB_TMO], 1u); break; } }
    }
    nloc = mine > 0u ? mine : 1u; nx = cnt > 0u ? cnt : 1u;
}

__device__ __forceinline__ void xcd_barrier(const XcdBarrier& b) {
    asm volatile("s_waitcnt vmcnt(0)" ::: "memory");
    __syncthreads();
    if (threadIdx.x == 0) {
        unsigned* bar = b.bar;
        __builtin_amdgcn_s_waitcnt(0);
        unsigned nloc = b.st[0], nx = b.st[1];
        if (nloc == 0u) { xcd_barrier_complete(bar, b.x, nloc, nx); b.st[0] = nloc; b.st[1] = nx; }
        const unsigned old = xb_add(&bar[XB_XSUB(b.x)], 1u);
        const unsigned gen = old / nloc;
        if (old + 1u == (gen + 1u) * nloc) {
            __builtin_amdgcn_fence(__ATOMIC_RELEASE, "agent");
            asm volatile("s_waitcnt vmcnt(0)" ::: "memory");
            const unsigned og = xb_add(&bar[XB_TOP], 1u);
            const unsigned tg = og / nx;
            if (og + 1u == (tg + 1u) * nx) xb_add(&bar[XB_TOPGEN], 1u);
            else XB_SPIN(xb_ld(&bar[XB_TOPGEN]) == tg, bar);
            __builtin_amdgcn_fence(__ATOMIC_ACQUIRE, "agent");
            xb_add(&bar[XB_XGEN(b.x)], 1u);
            asm volatile("s_waitcnt vmcnt(0)" ::: "memory");
        } else {
            XB_SPIN(xb_ld(&bar[XB_XGEN(b.x)]) == gen, bar);
            __builtin_amdgcn_fence(__ATOMIC_ACQUIRE, "agent");
            asm volatile("s_waitcnt vmcnt(0)" ::: "memory");
        }
    }
    __syncthreads();
}
constexpr int NWAVES = 8, NTHR = 512;
constexpr int D = 1024, T = 4096, CT = 256, NB = 4, NH = 8, DK = 128, FF = 4096, INT = 11296;
constexpr int ML = NB * T, MC = NB * CT, MR = ML + MC;
constexpr int NCH = 68;
constexpr float EPS = 1e-6f;
constexpr int NW1 = 11520, R_QKV = 0, R_AB = 3072, R_G2 = 3328, R_GA = 7424, R_GB = 8448, R_MG = 9472;
constexpr int N_G1 = 3328, N_G2 = 4096, N_G3 = 4096;
constexpr size_t MiB = 1u << 20;
constexpr size_t WS_CTL = 0, CTL_ZERO_BYTES = 1 * MiB;
constexpr size_t WS_MOD = 1 * MiB, WS_LB = WS_MOD + 128 * 1024;
constexpr size_t WS_LA = 1 * MiB + 512 * 1024, WS_BE = 2 * MiB + 768 * 1024;
constexpr size_t WS_ZQ = 4 * MiB;
constexpr size_t WS_QKVC = 106 * MiB;
constexpr size_t WS_TM = 208 * MiB;
constexpr size_t WS_WSM = 242 * MiB;
constexpr size_t WS_END = 256 * MiB;
constexpr size_t DO_H = 0;
constexpr size_t DO_WIN = 34 * MiB;
constexpr size_t DO_GB = 57 * MiB;
constexpr int CW_TMO = 0, CW_BAR = 4096, CW_ERR = 131072;
constexpr int LDS_BYTES = 147456, MISC_OFF = LDS_BYTES - 256;

struct Args { const float* in[19]; float* out; unsigned char* ws; int ph_lo, ph_hi, li, pad; };
static_assert(sizeof(Args) == 19 * 8 + 8 + 8 + 16, "Args has no padding");

struct Frame {
    LAS unsigned char* lds; volatile LAS unsigned* MISC; gu32* ctl;
    int tid, lane, wave, vcu, G;
    const float *x, *c, *ctx, *c_ctx, *w_ada, *b_ada, *norm_g, *w_in, *conv_w, *a_log, *dt_bias, *gdn_nw, *lb_logits, *hgrn_nw, *w_ba, *w_bb, *w_out, *w1, *w2;
    float* out; unsigned char* ws; unsigned char* dob;
};

__device__ __forceinline__ void p0_transpose_item(const float* W, int ldw, int k0, int c0, bf16* WT, int ldt, int r0, LAS float* scr, int lane) {
#pragma unroll 8
    for (int i = 0; i < 32; ++i) { const int kk = 2 * i + (lane >> 5); scr[kk * 33 + (lane & 31)] = W[(size_t)(k0 + kk) * ldw + c0 + (lane & 31)]; }
    LDS_WAIT(); asm volatile("" ::: "memory");
    const int c = lane & 7;
#pragma unroll
    for (int j = 0; j < 4; ++j) { const int n = (lane >> 3) + 8 * j; const LAS float* s = scr + (8 * c) * 33 + n;
        v4u o; o.x = pk2(s[0 * 33], s[1 * 33]); o.y = pk2(s[2 * 33], s[3 * 33]); o.z = pk2(s[4 * 33], s[5 * 33]); o.w = pk2(s[6 * 33], s[7 * 33]);
        *(GAS v4u*)(WT + (size_t)(r0 + n) * ldt + k0 + 8 * c) = o; }
    LDS_WAIT(); asm volatile("" ::: "memory");
}
__device__ __forceinline__ void p0_prologue(Frame& F) {
    LAS float* scr = (LAS float*)(F.lds + F.wave * 8704);
    const int gw = F.vcu * NWAVES + F.wave, NGW = F.G * NWAVES;
    bf16* WinT = (bf16*)(F.dob + DO_WIN); bf16* WaT = (bf16*)(F.ws + WS_WSM); bf16* WbT = WaT + (size_t)D * D; bf16* WoT = WbT + (size_t)D * D; bf16* W1T = WoT + (size_t)D * D;
    if (F.vcu < 192) {
        LAS float* sil = (LAS float*)(F.lds + 8 * 8704);
        LAS float* part = (LAS float*)(F.lds + 8 * 8704 + 20480);
        for (int i = F.tid; i < 5 * D; i += NTHR) { const int r = i >> 10, k = i & 1023; sil[i] = siluf(r < 4 ? F.c[r * D + k] : F.c_ctx[k]); }
        __syncthreads();
        for (int cb = F.vcu; cb < 192; cb += F.G) {
            const int n = cb * 32 + (F.lane & 31), kh = F.lane >> 5;
            float a0 = 0.f, a1 = 0.f, a2 = 0.f, a3 = 0.f, a4 = 0.f;
#pragma unroll 16
            for (int i = 0; i < 64; ++i) { const int k = F.wave * 128 + 2 * i + kh; const float w = F.w_ada[(size_t)k * 6 * D + n];
                a0 += sil[k] * w; a1 += sil[D + k] * w; a2 += sil[2 * D + k] * w; a3 += sil[3 * D + k] * w; a4 += sil[4 * D + k] * w; }
            a0 += __shfl_xor(a0, 32); a1 += __shfl_xor(a1, 32); a2 += __shfl_xor(a2, 32); a3 += __shfl_xor(a3, 32); a4 += __shfl_xor(a4, 32);
            if (F.lane < 32) { part[(F.wave * 5 + 0) * 32 + F.lane] = a0; part[(F.wave * 5 + 1) * 32 + F.lane] = a1; part[(F.wave * 5 + 2) * 32 + F.lane] = a2; part[(F.wave * 5 + 3) * 32 + F.lane] = a3; part[(F.wave * 5 + 4) * 32 + F.lane] = a4; }
            __syncthreads();
            if (F.tid < 160) { const int r = F.tid >> 5, cc = F.tid & 31; float s = 0.f;
#pragma unroll
                for (int w = 0; w < 8; ++w) s += part[(w * 5 + r) * 32 + cc];
                const int col = cb * 32 + cc; ((float*)(F.ws + WS_MOD))[r * 6 * D + col] = s + F.b_ada[col]; }
            __syncthreads();
        }
    }
    if (F.vcu == F.G - 1) {
        float* lb = (float*)(F.ws + WS_LB);
        for (int i = F.tid; i < 2 * D; i += NTHR) { const float l0 = F.lb_logits[i], l1 = F.lb_logits[2 * D + i], m = fmaxf(l0, l1), e0 = __expf(l0 - m), e1 = __expf(l1 - m); lb[i] = e0 / (e0 + e1); }
    }
    { v4u z = {0u, 0u, 0u, 0u}; GAS v4u* p = (GAS v4u*)(WinT + (size_t)(R_AB + 32) * D); const int n16 = 224 * D * 2 / 16;
      for (int i = F.vcu * NTHR + F.tid; i < n16; i += F.G * NTHR) p[i] = z; }
    constexpr int NITEMS = 16 * (96 + 1 + 128 + 32 + 32 + 64 + 32 + 32 + 32 + 128);
    for (int it = gw; it < NITEMS; it += NGW) {
        int r = it;
#define TRSEG(W_, ldw_, K_, c0_, ncols_, WT_, ldt_, r0_) { const int nblk_ = (ncols_) / 32, n_ = ((K_) / 64) * nblk_; \
            if (r < n_) { const int kb_ = r / nblk_, nb_ = r % nblk_; p0_transpose_item(W_, ldw_, 64 * kb_, (c0_) + 32 * nb_, WT_, ldt_, (r0_) + 32 * nb_, scr, F.lane); continue; } r -= n_; }
        TRSEG(F.w_in, INT, D, 0, 3072, WinT, D, R_QKV)
        TRSEG(F.w_in, INT, D, 4096, 32, WinT, D, R_AB)
        TRSEG(F.w_in, INT, D, 4128, 4096, WinT, D, R_G2)
        TRSEG(F.w_in, INT, D, 3072, 1024, WinT, D, R_GA)
        TRSEG(F.w_in, INT, D, 8224, 1024, WinT, D, R_GB)
        TRSEG(F.w_in, INT, D, 9248, 2048, WinT, D, R_MG)
        TRSEG(F.w_ba, D, D, 0, D, WaT, D, 0)
        TRSEG(F.w_bb, D, D, 0, D, WbT, D, 0)
        TRSEG(F.w_out, D, D, 0, D, WoT, D, 0)
        TRSEG(F.w1, FF, D, 0, FF, W1T, D, 0)
#undef TRSEG
    }
}
__device__ __forceinline__ void p1_hrows(Frame& F) {
    const int gw = F.vcu * NWAVES + F.wave, NGW = F.G * NWAVES;
    bf16* H = (bf16*)(F.dob + DO_H); const float* mod = (const float*)(F.ws + WS_MOD);
    for (int m = gw; m < MR; m += NGW) {
        const float* xr = m < ML ? F.x + (size_t)m * D : F.ctx + (size_t)(m - ML) * D;
        const float* mr = mod + (size_t)(m < ML ? (m >> 12) : 4) * 6 * D;
        const GAS f32x4* xp = (const GAS f32x4*)xr + F.lane;
        f32x4 v[4]; float s = 0.f;
#pragma unroll
        for (int j = 0; j < 4; ++j) { v[j] = xp[64 * j]; s += (v[j].x * v[j].x + v[j].y * v[j].y) + (v[j].z * v[j].z + v[j].w * v[j].w); }
        const float inv = 1.0f / sqrtf(wave_sum(s) * (1.f / D) + EPS);
        GAS v2u* o8 = (GAS v2u*)(H + (size_t)m * D) + F.lane;
#pragma unroll
        for (int j = 0; j < 4; ++j) { const int col = 4 * F.lane + 256 * j;
            const f32x4 g = *(const f32x4*)(F.norm_g + col), sh = *(const f32x4*)(mr + col), sc = *(const f32x4*)(mr + D + col);
            const f32x4 h = (v[j] * inv * g) * (sc + 1.0f) + sh;
            v2u o; o.x = pk2(h.x, h.y); o.y = pk2(h.z, h.w); o8[64 * j] = o; }
    }
}
struct EpiG1 {
    static constexpr bool PERM = true, AFTER_DRAIN = false;
    bf16* Zq; float* la; float* be; const float* a_log; const float* dt_bias;
    __device__ __forceinline__ void operator()(const pg8::f32x4 (&acc)[2][2][4][2], const pg8::Unit& u, int wr, int wc, int fr, int fq) const {
        const int row0 = u.pm * 256 + wr * 64 + fr;
        if (u.pn < 12) {
            const int col0 = u.pn * 256 + wc * 32 + 8 * fq;
#pragma unroll
            for (int ai = 0; ai < 2; ++ai)
#pragma unroll
                for (int m = 0; m < 4; ++m) { bf16* rowp = Zq + (size_t)(row0 + ai * 128 + m * 16) * 3072 + col0;
#pragma unroll
                    for (int bj = 0; bj < 2; ++bj) { const pg8::f32x4 v0 = acc[ai][bj][m][0], v1 = acc[ai][bj][m][1];
                        pg8::u32x4 w; w.x = pg8::cvt_pk_bf16(v0[0], v0[1]); w.y = pg8::cvt_pk_bf16(v0[2], v0[3]); w.z = pg8::cvt_pk_bf16(v1[0], v1[1]); w.w = pg8::cvt_pk_bf16(v1[2], v1[3]);
                        *(pg8::u32x4*)(rowp + bj * 128) = w; } }
        } else if (wc == 0) {
#pragma unroll
            for (int n = 0; n < 2; ++n) { const int c0 = 8 * fq + 4 * n;
                if (c0 < 16) { const f32x4 al = *(const f32x4*)(a_log + c0), dt = *(const f32x4*)(dt_bias + c0);
#pragma unroll
                    for (int ai = 0; ai < 2; ++ai)
#pragma unroll
                        for (int m = 0; m < 4; ++m) { const pg8::f32x4 v = acc[ai][0][m][n]; f32x4 o;
                            o.x = -__expf(al.x) * softplusf(v[0] + dt.x); o.y = -__expf(al.y) * softplusf(v[1] + dt.y); o.z = -__expf(al.z) * softplusf(v[2] + dt.z); o.w = -__expf(al.w) * softplusf(v[3] + dt.w);
                            *(f32x4*)(la + (size_t)(row0 + ai * 128 + m * 16) * 16 + c0) = o; }
                } else {
#pragma unroll
                    for (int ai = 0; ai < 2; ++ai)
#pragma unroll
                        for (int m = 0; m < 4; ++m) { const pg8::f32x4 v = acc[ai][0][m][n]; f32x4 o; o.x = sigm(v[0]); o.y = sigm(v[1]); o.z = sigm(v[2]); o.w = sigm(v[3]);
                            *(f32x4*)(be + (size_t)(row0 + ai * 128 + m * 16) * 16 + (c0 - 16)) = o; }
                } }
        }
    }
};
namespace prep {
constexpr int ST = 0, KS = 50688, AC = 67072, GBL = 132608;
constexpr int NUNITS = NB * NCH * 2;
}
__device__ __forceinline__ int chunk_tok0(int b, int n) { return n < 4 ? ML + b * CT + 64 * n : b * T + 64 * (n - 4); }

__device__ __forceinline__ void tri_solve_lower(const LAS float* Ab, int c, float (&X)[64]) {
    int z0 = 0, z1 = 0;
#pragma unroll
    for (int i = 0; i < 64; ++i) {
        const LAS float* row = Ab + i * 64 + z0;
        float s0 = (i == c) ? 1.f : 0.f, s1 = 0.f, s2 = 0.f, s3 = 0.f;
#pragma unroll
        for (int jj = 0; jj < (i + 3) / 4; ++jj) {
            const f32x4 a = *(const LAS f32x4*)(row + 4 * jj);
            if (4 * jj + 0 < i) s0 -= a.x * X[4 * jj + 0];
            if (4 * jj + 1 < i) s1 -= a.y * X[4 * jj + 1];
            if (4 * jj + 2 < i) s2 -= a.z * X[4 * jj + 2];
            if (4 * jj + 3 < i) s3 -= a.w * X[4 * jj + 3];
        }
        X[i] = (s0 + s1) + (s2 + s3);
        z0 = z1; int t = 0; asm volatile("" : "+v"(t), "+v"(X[i])); z1 = t;
    }
}
__device__ __forceinline__ void tri_solve_upper(const LAS float* Ab, int c, float (&X)[64]) {
    int z0 = 0, z1 = 0;
#pragma unroll
    for (int i = 63; i >= 0; --i) {
        const LAS float* row = Ab + i * 64 + z0;
        float s0 = (i == c) ? 1.f : 0.f, s1 = 0.f, s2 = 0.f, s3 = 0.f;
#pragma unroll
        for (int jj = (i + 1) / 4; jj < 16; ++jj) {
            const f32x4 a = *(const LAS f32x4*)(row + 4 * jj);
            if (4 * jj + 0 > i) s0 -= a.x * X[4 * jj + 0];
            if (4 * jj + 1 > i) s1 -= a.y * X[4 * jj + 1];
            if (4 * jj + 2 > i) s2 -= a.z * X[4 * jj + 2];
            if (4 * jj + 3 > i) s3 -= a.w * X[4 * jj + 3];
        }
        X[i] = (s0 + s1) + (s2 + s3);
        z0 = z1; int t = 0; asm volatile("" : "+v"(t), "+v"(X[i])); z1 = t;
    }
}

__device__ __forceinline__ void p3_gdn_prep(Frame& F) {
    using namespace prep;
    const bf16* Zq = (const bf16*)(F.ws + WS_ZQ); bf16* QKVc = (bf16*)(F.ws + WS_QKVC); bf16* TM = (bf16*)(F.ws + WS_TM); float* GB = (float*)(F.dob + DO_GB);
    const float* la = (const float*)(F.ws + WS_LA); const float* be = (const float*)(F.ws + WS_BE);
    LAS unsigned char* st = F.lds + ST; LAS unsigned char* ks = F.lds + KS; LAS float* ac = (LAS float*)(F.lds + AC); LAS float* gbl = (LAS float*)(F.lds + GBL);
    const int wave = F.wave;
    for (int unit = F.vcu; unit < NUNITS; unit += F.G) {
        int tid = F.tid; asm volatile("" : "+v"(tid));
        const int lane = tid & 63;
        const int hg = unit & 1, n = (unit >> 1) % NCH, b = (unit >> 1) / NCH;
        const bool isctx = n < 4; const int r = n - 4;
        const int tok0 = chunk_tok0(b, n);
        __syncthreads();
        { const int hl = wave >> 1, dir = wave & 1, h = hg * 4 + hl;
          float g = la[(size_t)(tok0 + lane) * 16 + dir * 8 + h]; const float bt = be[(size_t)(tok0 + lane) * 16 + dir * 8 + h];
          if (dir == 0) {
#pragma unroll
              for (int o = 1; o < 64; o <<= 1) { const float t = __shfl_up(g, o); if (lane >= o) g += t; }
          } else {
#pragma unroll
              for (int o = 1; o < 64; o <<= 1) { const float t = __shfl_down(g, o); if (lane + o < 64) g += t; }
          }
          gbl[((hl * 2 + dir) * 2 + 0) * 64 + lane] = g; gbl[((hl * 2 + dir) * 2 + 1) * 64 + lane] = bt;
          float* gb = GB + ((size_t)((b * NCH + n) * NH + h) * 2 + dir) * 128; const int id = dir == 0 ? lane : 63 - lane;
          gb[id] = g; gb[64 + id] = bt; }
        v4u pre[6]; v4u prehalo;
#define P3_ISSUE(part_) do { const int hl_ = (part_) / 3, p_ = (part_) % 3, cb_ = p_ * 1024 + (hg * 4 + hl_) * 128; \
            _Pragma("unroll") for (int k = 0; k < 6; ++k) { const int q = tid + 512 * k, dy = q >> 10, c = (q >> 4) & 63, k16 = q & 15; \
                bool ok; int tok; \
                if (isctx) { ok = dy == 1; tok = tok0 + c; } else { const int rr = r + dy - 1; ok = rr >= 0 && rr < 64; tok = b * T + rr * 64 + c; } \
                pre[k] = ok ? *(const GAS v4u*)(Zq + (size_t)tok * 3072 + cb_ + k16 * 8) : (v4u){0u, 0u, 0u, 0u}; } \
            prehalo = (v4u){0u, 0u, 0u, 0u}; \
            if (isctx && (tid >> 5) == 1) { const int side = (tid >> 4) & 1, k16 = tid & 15, t = side == 0 ? 64 * n - 1 : 64 * n + 64; \
                if (t >= 0 && t < CT) prehalo = *(const GAS v4u*)(Zq + (size_t)(ML + b * CT + t) * 3072 + cb_ + k16 * 8); } } while (0)
        P3_ISSUE(0);
        for (int part = 0; part < 12; ++part) {
            const int hl = part / 3, p = part % 3, h = hg * 4 + hl, cb = p * 1024 + h * 128;
            __syncthreads();
#pragma unroll
            for (int k = 0; k < 6; ++k) { const int q = tid + 512 * k, dy = q >> 10, c = (q >> 4) & 63, k16 = q & 15;
                *(LAS v4u*)(st + ((dy * 66 + c + 1) * 256 + k16 * 16)) = pre[k]; }
            if (tid < 96) { const int dy = tid >> 5, side = (tid >> 4) & 1, k16 = tid & 15;
                *(LAS v4u*)(st + ((dy * 66 + side * 65) * 256 + k16 * 16)) = (dy == 1) ? prehalo : (v4u){0u, 0u, 0u, 0u}; }
            __syncthreads();
            if (part + 1 < 12) P3_ISSUE(part + 1);
            { const int ch4 = tid & 31, tg = tid >> 5, c0 = 4 * tg;
              float y[4][4];
#pragma unroll
              for (int j = 0; j < 4; ++j)
#pragma unroll
                  for (int e = 0; e < 4; ++e) y[j][e] = 0.f;
#pragma unroll
              for (int dy = 0; dy < 3; ++dy) {
                  float in[6][4];
#pragma unroll
                  for (int x = 0; x < 6; ++x) { const v2u w = *(const LAS v2u*)(st + ((dy * 66 + c0 + x) * 256 + ch4 * 8)); in[x][0] = bflo(w.x); in[x][1] = bfhi(w.x); in[x][2] = bflo(w.y); in[x][3] = bfhi(w.y); }
#pragma unroll
                  for (int dx = 0; dx < 3; ++dx) { const f32x4 w = *(const f32x4*)(F.conv_w + (size_t)(dy * 3 + dx) * 3072 + cb + 4 * ch4);
#pragma unroll
                      for (int j = 0; j < 4; ++j) { y[j][0] += w.x * in[j + dx][0]; y[j][1] += w.y * in[j + dx][1]; y[j][2] += w.z * in[j + dx][2]; y[j][3] += w.w * in[j + dx][3]; } }
              }
#pragma unroll
              for (int j = 0; j < 4; ++j) {
#pragma unroll
                  for (int e = 0; e < 4; ++e) y[j][e] = siluf(y[j][e]);
                  float sc = 1.f;
                  if (p < 2) { float s = (y[j][0] * y[j][0] + y[j][1] * y[j][1]) + (y[j][2] * y[j][2] + y[j][3] * y[j][3]);
#pragma unroll
                      for (int o = 1; o < 32; o <<= 1) s += __shfl_xor(s, o);
                      sc = (1.0f / sqrtf(s + EPS)) * (p == 0 ? 0.08838834764831845f : 1.0f); }
                  v2u o; o.x = pk2(y[j][0] * sc, y[j][1] * sc); o.y = pk2(y[j][2] * sc, y[j][3] * sc);
                  const int row = c0 + j;
                  *(GAS v2u*)(QKVc + (size_t)(tok0 + row) * 3072 + cb + 4 * ch4) = o;
                  if (p == 1) *(LAS v2u*)(ks + row * 256 + ((((ch4 >> 1) ^ (row & 7)) << 4) | ((ch4 & 1) << 3))) = o;
              } }
            if (p == 1) {
                __syncthreads();
                const int fr = lane & 15, fq = lane >> 4;
                LAS float* A = ac + hl * 4096;
                const LAS float* g0 = gbl + ((hl * 2 + 0) * 2 + 0) * 64; const LAS float* b0 = g0 + 64; const LAS float* g1 = gbl + ((hl * 2 + 1) * 2 + 0) * 64; const LAS float* b1 = g1 + 64;
#pragma unroll
                for (int tt = 0; tt < 2; ++tt) { const int t = 2 * wave + tt, ti = t >> 2, tj = t & 3;
                    pg8::f32x4 acc = {0.f, 0.f, 0.f, 0.f};
#pragma unroll
                    for (int kk = 0; kk < 4; ++kk) { const int ra = 16 * ti + fr, rb = 16 * tj + fr, ch = kk * 4 + fq;
                        const bf16x8 fa = *(const LAS bf16x8*)(ks + ra * 256 + ((ch ^ (ra & 7)) << 4)); const bf16x8 fb = *(const LAS bf16x8*)(ks + rb * 256 + ((ch ^ (rb & 7)) << 4));
                        acc = __builtin_amdgcn_mfma_f32_16x16x32_bf16(fa, fb, acc, 0, 0, 0); }
                    const int j = 16 * tj + fr;
#pragma unroll
                    for (int e = 0; e < 4; ++e) { const int i = 16 * ti + 4 * fq + e; float v = 0.f;
                        if (j < i) v = b0[i] * acc[e] * __expf(g0[i] - g0[j]);
                        else if (j > i) v = b1[i] * acc[e] * __expf(g1[i] - g1[j]);
                        A[i * 64 + j] = v; } }
            }
        }
        __syncthreads();
        { const int hl = wave >> 1, dir = wave & 1, h = hg * 4 + hl;
          const LAS float* A = ac + hl * 4096; float X[64]; int cl = lane; asm volatile("" : "+v"(cl));
          bf16* tm = TM + ((size_t)((b * NCH + n) * NH + h) * 2 + dir) * 4096;
          if (dir == 0) { tri_solve_lower(A, cl, X);
#pragma unroll
              for (int i = 0; i < 64; ++i) tm[i * 64 + lane] = (bf16)f2bf(X[i]);
          } else { tri_solve_upper(A, cl, X);
#pragma unroll
              for (int i = 0; i < 64; ++i) tm[(63 - i) * 64 + (63 - lane)] = (bf16)f2bf(X[i]);
          } }
    }
#undef P3_ISSUE
}
__device__ __forceinline__ unsigned off_b(unsigned row, unsigned ch) { return 256u * row + 16u * (ch ^ (((row & 3) << 2) | ((row >> 2) & 3))); }
__device__ __forceinline__ unsigned off64(unsigned row, unsigned ch) { return 128u * row + 16u * (ch ^ ((row >> 1) & 7)); }
__device__ __forceinline__ unsigned off_v(unsigned row, unsigned ch) { return 64u * row + 16u * (ch ^ ((row >> 1) & 3)); }
__device__ __forceinline__ unsigned tr_addr_b(unsigned lane, unsigned c, unsigned ks, unsigned t) { const unsigned g = lane >> 4, q = (lane & 15) >> 2, p = lane & 3; return off_b(32 * ks + 8 * g + 4 * t + q, 2 * c + (p >> 1)) + 8 * (p & 1); }
__device__ __forceinline__ unsigned tr_addr_v(unsigned lane, unsigned c, unsigned ks, unsigned t) { const unsigned g = lane >> 4, q = (lane & 15) >> 2, p = lane & 3; return off_v(32 * ks + 8 * g + 4 * t + q, 2 * c + (p >> 1)) + 8 * (p & 1); }
__device__ __forceinline__ bf16x8 tr_frag(unsigned a0, unsigned a1) {
    v2u r0, r1;
    asm volatile("ds_read_b64_tr_b16 %0, %2\n\tds_read_b64_tr_b16 %1, %3\n\ts_waitcnt lgkmcnt(0)" : "=&v"(r0), "=&v"(r1) : "v"(a0), "v"(a1) : "memory");
    v4u w; w.x = r0.x; w.y = r0.y; w.z = r1.x; w.w = r1.y; return __builtin_bit_cast(bf16x8, w);
}
namespace gscan {
constexpr int QS = 0, KSI = 16384, TP = 32768, TPP = 40960, VS = 49152, ATT = 53248, NW = 61440, STI = 77824, VN1 = 86016, VN2 = 90112, GF = 94208;
constexpr int NV = 32, NITEMS = NB * NH * 2 * 4;
}
constexpr size_t WS_OAF = 4 * MiB, WS_OAB = 36 * MiB;

__device__ __forceinline__ void p4_gdn_scan(Frame& F) {
    using namespace gscan;
    const bf16* QKVc = (const bf16*)(F.ws + WS_QKVC); const bf16* TM = (const bf16*)(F.ws + WS_TM); const float* GB = (const float*)(F.dob + DO_GB);
    LAS unsigned char* L = F.lds; const unsigned LB = (unsigned)(unsigned long long)F.lds;
    LAS float* eg = (LAS float*)(L + GF); LAS float* dg = eg + 64; LAS float* gs = eg + 128;
    const int wave = F.wave;
    for (int item = F.vcu; item < NITEMS; item += F.G) {
        int tid = F.tid; asm volatile("" : "+v"(tid));
        const int lane = tid & 63, fr = lane & 15, fq = lane >> 4;
        const int vs = item & 3, dir = (item >> 2) & 1, h = (item >> 3) & 7, b = item >> 6;
        bf16* Oout = (bf16*)(F.ws + (dir == 0 ? WS_OAF : WS_OAB));
        pg8::f32x4 Sacc[2] = {{0.f, 0.f, 0.f, 0.f}, {0.f, 0.f, 0.f, 0.f}};
        __syncthreads();
        for (int i = tid; i < 8192 / 4; i += NTHR) ((LAS unsigned*)(L + STI))[i] = 0u;
        v4u pq[2], pk[2], pv, pt; f32x4 pg0, pg1, pb0, pb1; float pgl, pgi;
#define P4_ISSUE(s_) do { const int nm_ = dir == 0 ? (s_) : ((s_) < 4 ? 3 - (s_) : 67 - ((s_) - 4)); const int tk0_ = chunk_tok0(b, nm_); \
        _Pragma("unroll") for (int k = 0; k < 2; ++k) { const int q = tid + 512 * k, i = q >> 4, ch = q & 15; const size_t ro = (size_t)(tk0_ + (dir == 0 ? i : 63 - i)) * 3072 + h * 128 + ch * 8; \
            pq[k] = *(const GAS v4u*)(QKVc + ro); pk[k] = *(const GAS v4u*)(QKVc + ro + 1024); } \
        if (tid < 256) { const int j = tid >> 2, ch = tid & 3; pv = *(const GAS v4u*)(QKVc + (size_t)(tk0_ + (dir == 0 ? j : 63 - j)) * 3072 + 2048 + h * 128 + NV * vs + ch * 8); } \
        const size_t ci_ = ((size_t)((b * NCH + nm_) * NH + h) * 2 + dir); \
        pt = *(const GAS v4u*)(TM + ci_ * 4096 + (tid >> 3) * 64 + (tid & 7) * 8); \
        const float* gb_ = GB + ci_ * 128; pg0 = *(const f32x4*)(gb_ + (tid & 7) * 8); pg1 = *(const f32x4*)(gb_ + (tid & 7) * 8 + 4); pb0 = *(const f32x4*)(gb_ + 64 + (tid & 7) * 8); pb1 = *(const f32x4*)(gb_ + 64 + (tid & 7) * 8 + 4); \
        pgl = gb_[63]; pgi = gb_[lane]; } while (0)
        P4_ISSUE(0);
        for (int s = 0; s < NCH; ++s) {
            const int nm = dir == 0 ? s : (s < 4 ? 3 - s : 67 - (s - 4)); const int tok0 = chunk_tok0(b, nm);
#pragma unroll
            for (int k = 0; k < 2; ++k) { const int q = tid + 512 * k, i = q >> 4, ch = q & 15; *(LAS v4u*)(L + QS + off_b(i, ch)) = pq[k]; *(LAS v4u*)(L + KSI + off_b(i, ch)) = pk[k]; }
            if (tid < 256) { const int j = tid >> 2, ch = tid & 3; *(LAS v4u*)(L + VS + off_v(j, ch)) = pv; }
            { const int i = tid >> 3, ch = tid & 7; const float glast = pgl;
              const float sg[8] = {pg0.x, pg0.y, pg0.z, pg0.w, pg1.x, pg1.y, pg1.z, pg1.w}, sb[8] = {pb0.x, pb0.y, pb0.z, pb0.w, pb1.x, pb1.y, pb1.z, pb1.w};
              const unsigned tw[4] = {pt.x, pt.y, pt.z, pt.w}; unsigned o1[4], o2[4];
#pragma unroll
              for (int e = 0; e < 4; ++e) { const float t0 = bflo(tw[e]), t1 = bfhi(tw[e]);
                  o1[e] = pk2(t0 * sb[2 * e] * __expf(sg[2 * e]), t1 * sb[2 * e + 1] * __expf(sg[2 * e + 1])); o2[e] = pk2(t0 * sb[2 * e], t1 * sb[2 * e + 1]); }
              *(LAS v4u*)(L + TP + off64(i, ch)) = (v4u){o1[0], o1[1], o1[2], o1[3]}; *(LAS v4u*)(L + TPP + off64(i, ch)) = (v4u){o2[0], o2[1], o2[2], o2[3]};
              if (tid < 64) { eg[tid] = __expf(pgi); dg[tid] = __expf(glast - pgi); gs[tid] = pgi; } }
            const float dlast = __expf(pgl);
            __syncthreads();
            if (s + 1 < NCH) P4_ISSUE(s + 1);
#pragma unroll
            for (int tt = 0; tt < 2; ++tt) { const int t = 2 * wave + tt, tj = t >> 2, ti = t & 3;
                pg8::f32x4 acc = {0.f, 0.f, 0.f, 0.f};
                if (tj <= ti) {
#pragma unroll
                    for (int ks = 0; ks < 4; ++ks) { const bf16x8 fa = *(const LAS bf16x8*)(L + KSI + off_b(16 * tj + fr, 4 * ks + fq)), fb = *(const LAS bf16x8*)(L + QS + off_b(16 * ti + fr, 4 * ks + fq));
                        acc = __builtin_amdgcn_mfma_f32_16x16x32_bf16(fa, fb, acc, 0, 0, 0); } }
                const int i = 16 * ti + fr, j0 = 16 * tj + 4 * fq; const float gi = gs[i]; float o[4];
#pragma unroll
                for (int e = 0; e < 4; ++e) { const int j = j0 + e; o[e] = (j <= i) ? acc[e] * __expf(gi - gs[j]) : 0.f; }
                *(LAS v2u*)(L + ATT + off64(i, j0 >> 3) + (j0 & 4) * 2) = (v2u){pk2(o[0], o[1]), pk2(o[2], o[3])}; }
            bf16x8 kf[2];
#pragma unroll
            for (int ks = 0; ks < 2; ++ks) kf[ks] = tr_frag(LB + KSI + tr_addr_b(lane, wave, ks, 0), LB + KSI + tr_addr_b(lane, wave, ks, 1));
#pragma unroll
            for (int ti = 0; ti < 4; ++ti) { pg8::f32x4 acc = {0.f, 0.f, 0.f, 0.f};
#pragma unroll
                for (int ks = 0; ks < 2; ++ks) { const bf16x8 fb = *(const LAS bf16x8*)(L + TP + off64(16 * ti + fr, 4 * ks + fq)); acc = __builtin_amdgcn_mfma_f32_16x16x32_bf16(kf[ks], fb, acc, 0, 0, 0); }
                const int i = 16 * ti + fr, c0 = 16 * wave + 4 * fq;
                *(LAS v2u*)(L + NW + off_b(i, c0 >> 3) + (c0 & 4) * 2) = (v2u){pk2(-acc[0], -acc[1]), pk2(-acc[2], -acc[3])}; }
            pg8::f32x4 oacc = {0.f, 0.f, 0.f, 0.f}; const int otv = wave >> 2, oti = wave & 3;
#pragma unroll
            for (int ks = 0; ks < 4; ++ks) { const bf16x8 fa = *(const LAS bf16x8*)(L + STI + off_b(16 * otv + fr, 4 * ks + fq)), fb = *(const LAS bf16x8*)(L + QS + off_b(16 * oti + fr, 4 * ks + fq));
                oacc = __builtin_amdgcn_mfma_f32_16x16x32_bf16(fa, fb, oacc, 0, 0, 0); }
            { const float e = eg[16 * oti + fr]; oacc = oacc * e; }
            __syncthreads();
            { const int ti = wave >> 1, tv = wave & 1; pg8::f32x4 acc = {0.f, 0.f, 0.f, 0.f};
#pragma unroll
              for (int ks = 0; ks < 2; ++ks) { const bf16x8 fa = *(const LAS bf16x8*)(L + TPP + off64(16 * ti + fr, 4 * ks + fq)); const bf16x8 fb = tr_frag(LB + VS + tr_addr_v(lane, tv, ks, 0), LB + VS + tr_addr_v(lane, tv, ks, 1));
                  acc = __builtin_amdgcn_mfma_f32_16x16x32_bf16(fa, fb, acc, 0, 0, 0); }
#pragma unroll
              for (int ks = 0; ks < 4; ++ks) { const bf16x8 fa = *(const LAS bf16x8*)(L + NW + off_b(16 * ti + fr, 4 * ks + fq)), fb = *(const LAS bf16x8*)(L + STI + off_b(16 * tv + fr, 4 * ks + fq));
                  acc = __builtin_amdgcn_mfma_f32_16x16x32_bf16(fa, fb, acc, 0, 0, 0); }
              const int v = 16 * tv + fr, i0 = 16 * ti + 4 * fq; const f32x4 d4 = *(const LAS f32x4*)(dg + i0);
              *(LAS v2u*)(L + VN1 + off64(v, i0 >> 3) + (i0 & 4) * 2) = (v2u){pk2(acc[0], acc[1]), pk2(acc[2], acc[3])};
              *(LAS v2u*)(L + VN2 + off64(v, i0 >> 3) + (i0 & 4) * 2) = (v2u){pk2(acc[0] * d4.x, acc[1] * d4.y), pk2(acc[2] * d4.z, acc[3] * d4.w)}; }
            __syncthreads();
#pragma unroll
            for (int ks = 0; ks < 2; ++ks) { const bf16x8 fa = *(const LAS bf16x8*)(L + VN1 + off64(16 * otv + fr, 4 * ks + fq)), fb = *(const LAS bf16x8*)(L + ATT + off64(16 * oti + fr, 4 * ks + fq));
                oacc = __builtin_amdgcn_mfma_f32_16x16x32_bf16(fa, fb, oacc, 0, 0, 0); }
            if (nm >= 4) { const int i = 16 * oti + fr, v0 = 16 * otv + 4 * fq; const int tok = tok0 + (dir == 0 ? i : 63 - i);
                *(GAS v2u*)(Oout + (size_t)tok * 1024 + h * 128 + NV * vs + v0) = (v2u){pk2(oacc[0], oacc[1]), pk2(oacc[2], oacc[3])}; }
#pragma unroll
            for (int tv = 0; tv < 2; ++tv) { pg8::f32x4 acc = Sacc[tv] * dlast;
#pragma unroll
                for (int ks = 0; ks < 2; ++ks) { const bf16x8 fb = *(const LAS bf16x8*)(L + VN2 + off64(16 * tv + fr, 4 * ks + fq)); acc = __builtin_amdgcn_mfma_f32_16x16x32_bf16(kf[ks], fb, acc, 0, 0, 0); }
                Sacc[tv] = acc; }
            __syncthreads();
#pragma unroll
            for (int tv = 0; tv < 2; ++tv) { const int v = 16 * tv + fr, c0 = 16 * wave + 4 * fq;
                *(LAS v2u*)(L + STI + off_b(v, c0 >> 3) + (c0 & 4) * 2) = (v2u){pk2(Sacc[tv][0], Sacc[tv][1]), pk2(Sacc[tv][2], Sacc[tv][3])}; }
        }
#undef P4_ISSUE
    }
}
struct EpiStore {
    static constexpr bool PERM = true, AFTER_DRAIN = false;
    bf16* O; int ldc;
    __device__ __forceinline__ void operator()(const pg8::f32x4 (&acc)[2][2][4][2], const pg8::Unit& u, int wr, int wc, int fr, int fq) const {
        const int row0 = u.pm * 256 + wr * 64 + fr, col0 = u.pn * 256 + wc * 32 + 8 * fq;
#pragma unroll
        for (int ai = 0; ai < 2; ++ai)
#pragma unroll
            for (int m = 0; m < 4; ++m) { bf16* rowp = O + (size_t)(row0 + ai * 128 + m * 16) * ldc + col0;
#pragma unroll
                for (int bj = 0; bj < 2; ++bj) { const pg8::f32x4 v0 = acc[ai][bj][m][0], v1 = acc[ai][bj][m][1];
                    pg8::u32x4 w; w.x = pg8::cvt_pk_bf16(v0[0], v0[1]); w.y = pg8::cvt_pk_bf16(v0[2], v0[3]); w.z = pg8::cvt_pk_bf16(v1[0], v1[1]); w.w = pg8::cvt_pk_bf16(v1[2], v1[3]);
                    *(pg8::u32x4*)(rowp + bj * 128) = w; } }
    }
};
constexpr size_t WS_NA = 68 * MiB, WS_NB = 100 * MiB;
constexpr size_t WS_ZH = 106 * MiB;
constexpr size_t WS_OBF = 4 * MiB, WS_OBB = 36 * MiB;
__device__ __forceinline__ void combine_norm(Frame& F, const bf16* Of, const bf16* Ob, const float* nw, bf16* N) {
    const int gw = F.vcu * NWAVES + F.wave, NGW = F.G * NWAVES; const int lane = F.lane;
    f32x4 w4[4];
#pragma unroll
    for (int j = 0; j < 4; ++j) w4[j] = *(const f32x4*)(nw + (16 * lane) % 128 + 4 * j);
    for (int t = gw; t < ML; t += NGW) {
        const size_t o = (size_t)t * 1024 + 16 * lane;
        const v4u a0 = *(const GAS v4u*)(Of + o), a1 = *(const GAS v4u*)(Of + o + 8), b0 = *(const GAS v4u*)(Ob + o), b1 = *(const GAS v4u*)(Ob + o + 8);
        const unsigned aw[8] = {a0.x, a0.y, a0.z, a0.w, a1.x, a1.y, a1.z, a1.w}, bw[8] = {b0.x, b0.y, b0.z, b0.w, b1.x, b1.y, b1.z, b1.w};
        float v[16]; float s = 0.f;
#pragma unroll
        for (int e = 0; e < 8; ++e) { v[2 * e] = bflo(aw[e]) + bflo(bw[e]); v[2 * e + 1] = bfhi(aw[e]) + bfhi(bw[e]); s += v[2 * e] * v[2 * e] + v[2 * e + 1] * v[2 * e + 1]; }
        s += __shfl_xor(s, 1); s += __shfl_xor(s, 2); s += __shfl_xor(s, 4);
        const float inv = 1.0f / sqrtf(s * (1.f / 128.f) + EPS);
        const float wv[16] = {w4[0].x, w4[0].y, w4[0].z, w4[0].w, w4[1].x, w4[1].y, w4[1].z, w4[1].w, w4[2].x, w4[2].y, w4[2].z, w4[2].w, w4[3].x, w4[3].y, w4[3].z, w4[3].w};
        unsigned ow[8];
#pragma unroll
        for (int e = 0; e < 8; ++e) ow[e] = pk2(v[2 * e] * inv * wv[2 * e], v[2 * e + 1] * inv * wv[2 * e + 1]);
        *(GAS v4u*)(N + o) = (v4u){ow[0], ow[1], ow[2], ow[3]}; *(GAS v4u*)(N + o + 8) = (v4u){ow[4], ow[5], ow[6], ow[7]};
    }
}
constexpr size_t WS_SG = 132 * MiB;
constexpr size_t WS_TMP = 4 * MiB;
constexpr size_t WS_MB = 196 * MiB;
constexpr size_t WS_W2T = 228 * MiB;
constexpr size_t WS_H2 = 68 * MiB;
constexpr size_t WS_HID = 100 * MiB;

struct EpiG3 {
    static constexpr bool PERM = true, AFTER_DRAIN = false;
    unsigned char* ws;
    __device__ __forceinline__ void operator()(const pg8::f32x4 (&acc)[2][2][4][2], const pg8::Unit& u, int wr, int wc, int fr, int fq) const {
        const int row0 = u.pm * 256 + wr * 64 + fr;
        const bool gate = u.pn >= 8;
        const size_t boff = gate ? WS_SG : (u.pn >= 4 ? WS_NB : WS_NA); bf16* base = (bf16*)(ws + boff); const int ldc = gate ? 2048 : 1024;
        const int col0 = (gate ? (u.pn - 8) : (u.pn & 3)) * 256 + wc * 32 + 8 * fq;
#pragma unroll
        for (int ai = 0; ai < 2; ++ai)
#pragma unroll
            for (int m = 0; m < 4; ++m) { bf16* rowp = base + (size_t)(row0 + ai * 128 + m * 16) * ldc + col0;
#pragma unroll
                for (int bj = 0; bj < 2; ++bj) { const pg8::f32x4 v0 = acc[ai][bj][m][0], v1 = acc[ai][bj][m][1];
                    float o[8] = {v0[0], v0[1], v0[2], v0[3], v1[0], v1[1], v1[2], v1[3]};
                    if (gate) {
#pragma unroll
                        for (int e = 0; e < 8; ++e) o[e] = sigm(o[e]);
                    } else { const v4u nv = *(const GAS v4u*)(rowp + bj * 128); const unsigned nw[4] = {nv.x, nv.y, nv.z, nv.w};
#pragma unroll
                        for (int e = 0; e < 4; ++e) { o[2 * e] = bflo(nw[e]) * siluf(o[2 * e]); o[2 * e + 1] = bfhi(nw[e]) * siluf(o[2 * e + 1]); } }
                    pg8::u32x4 w; w.x = pk2(o[0], o[1]); w.y = pk2(o[2], o[3]); w.z = pk2(o[4], o[5]); w.w = pk2(o[6], o[7]);
                    *(pg8::u32x4*)(rowp + bj * 128) = w; } }
    }
};
template <int PASS> struct EpiMerge {
    static constexpr bool PERM = false, AFTER_DRAIN = false;
    const bf16* SG; float* tmp; bf16* Mb;
    __device__ __forceinline__ void operator()(const pg8::f32x4 (&acc)[2][2][4][2], const pg8::Unit& u, int wr, int wc, int fr, int fq) const {
        const int row0 = u.pm * 256 + wr * 64 + fr, col0 = u.pn * 256 + wc * 32 + 4 * fq;
#pragma unroll
        for (int ai = 0; ai < 2; ++ai)
#pragma unroll
            for (int m = 0; m < 4; ++m) { const size_t r = (size_t)(row0 + ai * 128 + m * 16);
#pragma unroll
                for (int bj = 0; bj < 2; ++bj)
#pragma unroll
                    for (int n = 0; n < 2; ++n) { const int c = col0 + bj * 128 + n * 16; const pg8::f32x4 v = acc[ai][bj][m][n];
                        const v2u sg = *(const GAS v2u*)(SG + r * 2048 + (PASS ? 1024 : 0) + c);
                        f32x4 o; o.x = bflo(sg.x) * v[0]; o.y = bfhi(sg.x) * v[1]; o.z = bflo(sg.y) * v[2]; o.w = bfhi(sg.y) * v[3];
                        if (PASS == 0) *(f32x4*)(tmp + r * 1024 + c) = o;
                        else { const f32x4 t = *(const f32x4*)(tmp + r * 1024 + c); o = o + t; *(GAS v2u*)(Mb + r * 1024 + c) = (v2u){pk2(o.x, o.y), pk2(o.z, o.w)}; } } }
    }
};
struct EpiF32S {
    static constexpr bool PERM = false, AFTER_DRAIN = false;
    float* C; int ldc;
    __device__ __forceinline__ void operator()(const pg8::f32x4 (&acc)[2][2][4][2], const pg8::Unit& u, int wr, int wc, int fr, int fq) const {
        const int row0 = u.pm * 256 + wr * 64 + fr, col0 = u.pn * 256 + wc * 32 + 4 * fq;
#pragma unroll
        for (int ai = 0; ai < 2; ++ai)
#pragma unroll
            for (int m = 0; m < 4; ++m) { float* rowp = C + (size_t)(row0 + ai * 128 + m * 16) * ldc + col0;
#pragma unroll
                for (int bj = 0; bj < 2; ++bj)
#pragma unroll
                    for (int n = 0; n < 2; ++n) *(pg8::f32x4*)(rowp + bj * 128 + n * 16) = acc[ai][bj][m][n]; }
    }
};
struct EpiRelu2 {
    static constexpr bool PERM = true, AFTER_DRAIN = false;
    bf16* O; int ldc;
    __device__ __forceinline__ void operator()(const pg8::f32x4 (&acc)[2][2][4][2], const pg8::Unit& u, int wr, int wc, int fr, int fq) const {
        const int row0 = u.pm * 256 + wr * 64 + fr, col0 = u.pn * 256 + wc * 32 + 8 * fq;
#pragma unroll
        for (int ai = 0; ai < 2; ++ai)
#pragma unroll
            for (int m = 0; m < 4; ++m) { bf16* rowp = O + (size_t)(row0 + ai * 128 + m * 16) * ldc + col0;
#pragma unroll
                for (int bj = 0; bj < 2; ++bj) { pg8::f32x4 v0 = acc[ai][bj][m][0], v1 = acc[ai][bj][m][1];
#pragma unroll
                    for (int e = 0; e < 4; ++e) { const float a = fmaxf(v0[e], 0.f), b = fmaxf(v1[e], 0.f); v0[e] = a * a; v1[e] = b * b; }
                    pg8::u32x4 w; w.x = pg8::cvt_pk_bf16(v0[0], v0[1]); w.y = pg8::cvt_pk_bf16(v0[2], v0[3]); w.z = pg8::cvt_pk_bf16(v1[0], v1[1]); w.w = pg8::cvt_pk_bf16(v1[2], v1[3]);
                    *(pg8::u32x4*)(rowp + bj * 128) = w; } }
    }
};
__device__ __forceinline__ void rowwise_resid(Frame& F, const float* xin, const float* r, const float* g, int gt_off, float* xo, bf16* H2, const float* g2, int sh_off, int sc_off) {
    const int gw = F.vcu * NWAVES + F.wave, NGW = F.G * NWAVES; const float* mod = (const float*)(F.ws + WS_MOD);
    for (int m = gw; m < ML; m += NGW) {
        const float* mr = mod + (size_t)(m >> 12) * 6 * D;
        const GAS f32x4* rp = (const GAS f32x4*)(r + (size_t)m * D) + F.lane; const GAS f32x4* xp = (const GAS f32x4*)(xin + (size_t)m * D) + F.lane;
        f32x4 v[4], xv[4]; float s = 0.f;
#pragma unroll
        for (int j = 0; j < 4; ++j) { v[j] = rp[64 * j]; xv[j] = xp[64 * j]; s += (v[j].x * v[j].x + v[j].y * v[j].y) + (v[j].z * v[j].z + v[j].w * v[j].w); }
        const float inv = 1.0f / sqrtf(wave_sum(s) * (1.f / D) + EPS); float s2 = 0.f;
        GAS f32x4* op = (GAS f32x4*)(xo + (size_t)m * D) + F.lane;
#pragma unroll
        for (int j = 0; j < 4; ++j) { const int col = 4 * F.lane + 256 * j; const f32x4 gg = *(const f32x4*)(g + col), gt = *(const f32x4*)(mr + gt_off + col);
            xv[j] = xv[j] + gt * (v[j] * inv * gg); op[64 * j] = xv[j]; s2 += (xv[j].x * xv[j].x + xv[j].y * xv[j].y) + (xv[j].z * xv[j].z + xv[j].w * xv[j].w); }
        if (H2) { const float inv2 = 1.0f / sqrtf(wave_sum(s2) * (1.f / D) + EPS); GAS v2u* o8 = (GAS v2u*)(H2 + (size_t)m * D) + F.lane;
#pragma unroll
            for (int j = 0; j < 4; ++j) { const int col = 4 * F.lane + 256 * j; const f32x4 gg = *(const f32x4*)(g2 + col), sh = *(const f32x4*)(mr + sh_off + col), sc = *(const f32x4*)(mr + sc_off + col);
                const f32x4 h = (xv[j] * inv2 * gg) * (sc + 1.0f) + sh; o8[64 * j] = (v2u){pk2(h.x, h.y), pk2(h.z, h.w)}; } }
    }
}
__device__ __forceinline__ void w2_transpose(Frame& F) {
    LAS float* scr = (LAS float*)(F.lds + F.wave * 8704); const int gw = F.vcu * NWAVES + F.wave, NGW = F.G * NWAVES;
    bf16* W2T = (bf16*)(F.ws + WS_W2T);
    for (int it = gw; it < 64 * 32; it += NGW) { const int kb = it / 32, nb = it % 32; p0_transpose_item(F.w2, D, 64 * kb, 32 * nb, W2T, FF, 32 * nb, scr, F.lane); }
}
namespace hs2 {
constexpr int KE0 = 0, KE1 = 16384, VA0 = 32768, VA1 = 49152;
constexpr int QT = 0, KT = 16384, VS0 = 32768, VS1 = 49152, AI = 65536, STI = 73728;
constexpr int NITEMS = 256, GSTEPS = 17;
}
constexpr size_t WS_SL0 = 100 * MiB;
constexpr size_t DO_SL1 = 57 * MiB;
constexpr size_t WS_BS = WS_LA;
__device__ __forceinline__ void tr_frag2(unsigned a0, unsigned a1, unsigned b0, unsigned b1, bf16x8& fa, bf16x8& fb) {
    v2u r0, r1, r2, r3;
    asm volatile("ds_read_b64_tr_b16 %0, %4\n\tds_read_b64_tr_b16 %1, %5\n\tds_read_b64_tr_b16 %2, %6\n\tds_read_b64_tr_b16 %3, %7\n\ts_waitcnt lgkmcnt(0)"
                 : "=&v"(r0), "=&v"(r1), "=&v"(r2), "=&v"(r3) : "v"(a0), "v"(a1), "v"(b0), "v"(b1) : "memory");
    v4u w; w.x = r0.x; w.y = r0.y; w.z = r1.x; w.w = r1.y; fa = __builtin_bit_cast(bf16x8, w);
    w.x = r2.x; w.y = r2.y; w.z = r3.x; w.w = r3.y; fb = __builtin_bit_cast(bf16x8, w);
}
__device__ __forceinline__ void p7_hgrn_scan2(Frame& F, const XcdBarrier& bar) {
    using namespace hs2;
    const bf16* Zh = (const bf16*)(F.ws + WS_ZH); const float* lbp = (const float*)(F.ws + WS_LB);
    float* BS = (float*)(F.ws + WS_BS);
    LAS unsigned char* L = F.lds; const unsigned LB = (unsigned)(unsigned long long)F.lds;
    const int wave = F.wave;
    for (int item = F.vcu; item < NITEMS; item += F.G) {
        int tid = F.tid; asm volatile("" : "+v"(tid));
        const int lane = tid & 63, fr = lane & 15, fq = lane >> 4, cp = lane & 7, tg = lane >> 3;
        const int grp = item & 3, dir = (item >> 2) & 1, h = (item >> 3) & 7, b = item >> 6;
        if (grp == 3) continue;
        const int c0 = 16 * wave + 2 * cp;
        const float lb0 = lbp[dir * 1024 + h * 128 + c0], lb1 = lbp[dir * 1024 + h * 128 + c0 + 1];
        pg8::f32x4 Sacc[8]; float bs[4] = {0.f, 0.f, 0.f, 0.f};
#pragma unroll
        for (int tv = 0; tv < 8; ++tv) Sacc[tv] = (pg8::f32x4){0.f, 0.f, 0.f, 0.f};
        __syncthreads();
        unsigned pf[8]; v4u pv[2];
#define H1_ISSUE(s_) do { const int nm_ = dir == 0 ? (s_) : ((s_) < 4 ? 3 - (s_) : 67 - ((s_) - 4)); const int tk0_ = chunk_tok0(b, nm_); \
        _Pragma("unroll") for (int i = 0; i < 8; ++i) { const int t = 8 * tg + i; pf[i] = *(const GAS unsigned*)(Zh + (size_t)(tk0_ + (dir == 0 ? t : 63 - t)) * 4096 + dir * 1024 + h * 128 + c0); } \
        _Pragma("unroll") for (int k = 0; k < 2; ++k) { const int q = tid + 512 * k, j = q >> 4, ch = q & 15; pv[k] = *(const GAS v4u*)(Zh + (size_t)(tk0_ + (dir == 0 ? j : 63 - j)) * 4096 + 3072 + h * 128 + ch * 8); } } while (0)
        const int s_begin = grp * GSTEPS;
        H1_ISSUE(s_begin);
        for (int s = s_begin; s < s_begin + GSTEPS; ++s) {
            const int KE = (s & 1) ? KE1 : KE0, VA = (s & 1) ? VA1 : VA0;
            float cum0[8], cum1[8], kk0[8], kk1[8]; float x0 = 0.f, x1 = 0.f;
#pragma unroll
            for (int i = 0; i < 8; ++i) { const float z0 = bflo(pf[i]), z1 = bfhi(pf[i]);
                const float em0 = __expf(-z0), em1 = __expf(-z1), sg0 = 1.f / (1.f + em0), sg1 = 1.f / (1.f + em1);
                x0 += __logf(lb0 + (1.f - lb0) * sg0); x1 += __logf(lb1 + (1.f - lb1) * sg1); cum0[i] = x0; cum1[i] = x1;
                kk0[i] = (1.f - lb0) * em0 * sg0; kk1[i] = (1.f - lb1) * em1 * sg1; }
            float in0 = x0, in1 = x1;
            { float t0 = __shfl_up(in0, 8), t1 = __shfl_up(in1, 8); if (tg >= 1) { in0 += t0; in1 += t1; }
              t0 = __shfl_up(in0, 16); t1 = __shfl_up(in1, 16); if (tg >= 2) { in0 += t0; in1 += t1; }
              t0 = __shfl_up(in0, 32); t1 = __shfl_up(in1, 32); if (tg >= 4) { in0 += t0; in1 += t1; } }
            const float bl0 = __shfl(in0, 56 + cp), bl1 = __shfl(in1, 56 + cp), ex0 = in0 - x0, ex1 = in1 - x1;
#pragma unroll
            for (int i = 0; i < 8; ++i) { const int t = 8 * tg + i;
                *(LAS unsigned*)(L + KE + off_b(t, 2 * wave + (cp >> 2)) + (cp & 3) * 4) = pk2(kk0[i] * __expf(bl0 - (ex0 + cum0[i])), kk1[i] * __expf(bl1 - (ex1 + cum1[i]))); }
#pragma unroll
            for (int k = 0; k < 2; ++k) { const int q = tid + 512 * k, j = q >> 4, ch = q & 15; *(LAS v4u*)(L + VA + off_b(j, ch)) = pv[k]; }
            float ebl[4];
            { const float a0 = __shfl(bl0, 2 * fq), a1 = __shfl(bl1, 2 * fq), b0 = __shfl(bl0, 2 * fq + 1), b1 = __shfl(bl1, 2 * fq + 1);
              bs[0] += a0; bs[1] += a1; bs[2] += b0; bs[3] += b1; ebl[0] = __expf(a0); ebl[1] = __expf(a1); ebl[2] = __expf(b0); ebl[3] = __expf(b1); }
            __syncthreads();
            if (s + 1 < s_begin + GSTEPS) H1_ISSUE(s + 1);
            bf16x8 kf[2]; tr_frag2(LB + KE + tr_addr_b(lane, wave, 0, 0), LB + KE + tr_addr_b(lane, wave, 0, 1), LB + KE + tr_addr_b(lane, wave, 1, 0), LB + KE + tr_addr_b(lane, wave, 1, 1), kf[0], kf[1]);
#pragma unroll
            for (int tv = 0; tv < 8; ++tv) { bf16x8 vf[2]; tr_frag2(LB + VA + tr_addr_b(lane, tv, 0, 0), LB + VA + tr_addr_b(lane, tv, 0, 1), LB + VA + tr_addr_b(lane, tv, 1, 0), LB + VA + tr_addr_b(lane, tv, 1, 1), vf[0], vf[1]);
                pg8::f32x4 p = {0.f, 0.f, 0.f, 0.f};
                p = __builtin_amdgcn_mfma_f32_16x16x32_bf16(kf[0], vf[0], p, 0, 0, 0); p = __builtin_amdgcn_mfma_f32_16x16x32_bf16(kf[1], vf[1], p, 0, 0, 0);
#pragma unroll
                for (int e = 0; e < 4; ++e) Sacc[tv][e] = ebl[e] * Sacc[tv][e] + p[e]; }
        }
#undef H1_ISSUE
        const int chain = b * NH + h;
        float* sl = (float*)(dir == 0 ? F.ws + WS_SL0 : F.dob + DO_SL1) + (size_t)(chain * 3 + grp) * 16384;
#pragma unroll
        for (int tv = 0; tv < 8; ++tv) *(pg8::f32x4*)(sl + ((wave * 8 + tv) * 64 + lane) * 4) = Sacc[tv];
        if (fr == 0) { float* bp = BS + (size_t)((dir * 32 + chain) * 3 + grp) * 128 + 16 * wave + 4 * fq; *(f32x4*)bp = (f32x4){bs[0], bs[1], bs[2], bs[3]}; }
    }
    xcd_barrier(bar);
    for (int item = F.vcu; item < NITEMS; item += F.G) {
        int tid = F.tid; asm volatile("" : "+v"(tid));
        const int lane = tid & 63, fr = lane & 15, fq = lane >> 4, cp = lane & 7, tg = lane >> 3;
        const int grp = item & 3, dir = (item >> 2) & 1, h = (item >> 3) & 7, b = item >> 6, chain = b * NH + h;
        const int c0 = 16 * wave + 2 * cp;
        bf16* Oout = (bf16*)(F.ws + (dir == 0 ? WS_OBF : WS_OBB));
        const float lb0 = lbp[dir * 1024 + h * 128 + c0], lb1 = lbp[dir * 1024 + h * 128 + c0 + 1];
        pg8::f32x4 Sacc[8];
#pragma unroll
        for (int tv = 0; tv < 8; ++tv) Sacc[tv] = (pg8::f32x4){0.f, 0.f, 0.f, 0.f};
        for (int g = 0; g < grp; ++g) {
            const float* sl = (const float*)(dir == 0 ? F.ws + WS_SL0 : F.dob + DO_SL1) + (size_t)(chain * 3 + g) * 16384;
            const f32x4 bd = *(const f32x4*)(BS + (size_t)((dir * 32 + chain) * 3 + g) * 128 + 16 * wave + 4 * fq);
            const float d[4] = {__expf(bd.x), __expf(bd.y), __expf(bd.z), __expf(bd.w)};
#pragma unroll
            for (int tv = 0; tv < 8; ++tv) { const pg8::f32x4 a = *(const pg8::f32x4*)(sl + ((wave * 8 + tv) * 64 + lane) * 4);
#pragma unroll
                for (int e = 0; e < 4; ++e) Sacc[tv][e] = d[e] * Sacc[tv][e] + a[e]; } }
        __syncthreads();
        unsigned pf[8], pqb[8]; v4u pv[2];
#define H2_ISSUE(s_) do { const int nm_ = dir == 0 ? (s_) : ((s_) < 4 ? 3 - (s_) : 67 - ((s_) - 4)); const int tk0_ = chunk_tok0(b, nm_); \
        _Pragma("unroll") for (int i = 0; i < 8; ++i) { const int t = 8 * tg + i; const size_t ro = (size_t)(tk0_ + (dir == 0 ? t : 63 - t)) * 4096; \
            pf[i] = *(const GAS unsigned*)(Zh + ro + dir * 1024 + h * 128 + c0); pqb[i] = *(const GAS unsigned*)(Zh + ro + 2048 + h * 128 + c0); } \
        _Pragma("unroll") for (int k = 0; k < 2; ++k) { const int q = tid + 512 * k, j = q >> 4, ch = q & 15; pv[k] = *(const GAS v4u*)(Zh + (size_t)(tk0_ + (dir == 0 ? j : 63 - j)) * 4096 + 3072 + h * 128 + ch * 8); } } while (0)
        const int s_begin = grp * GSTEPS;
        H2_ISSUE(s_begin);
        for (int s = s_begin; s < s_begin + GSTEPS; ++s) {
            const int nm = dir == 0 ? s : (s < 4 ? 3 - s : 67 - (s - 4)); const int tok0 = chunk_tok0(b, nm);
            const int VS = (s & 1) ? VS1 : VS0;
            float ebl[4], ebd[4];
            { float cum0[8], cum1[8], kk0[8], kk1[8], q0[8], q1[8]; float x0 = 0.f, x1 = 0.f;
#pragma unroll
              for (int i = 0; i < 8; ++i) { const float z0 = bflo(pf[i]), z1 = bfhi(pf[i]);
                  const float em0 = __expf(-z0), em1 = __expf(-z1), sg0 = 1.f / (1.f + em0), sg1 = 1.f / (1.f + em1);
                  x0 += __logf(lb0 + (1.f - lb0) * sg0); x1 += __logf(lb1 + (1.f - lb1) * sg1); cum0[i] = x0; cum1[i] = x1;
                  kk0[i] = (1.f - lb0) * em0 * sg0; kk1[i] = (1.f - lb1) * em1 * sg1;
                  const float y0 = bflo(pqb[i]), y1 = bfhi(pqb[i]); q0[i] = y0 / (1.f + __expf(-y0)) * 0.08838834764831845f; q1[i] = y1 / (1.f + __expf(-y1)) * 0.08838834764831845f; }
              float in0 = x0, in1 = x1;
              { float t0 = __shfl_up(in0, 8), t1 = __shfl_up(in1, 8); if (tg >= 1) { in0 += t0; in1 += t1; }
                t0 = __shfl_up(in0, 16); t1 = __shfl_up(in1, 16); if (tg >= 2) { in0 += t0; in1 += t1; }
                t0 = __shfl_up(in0, 32); t1 = __shfl_up(in1, 32); if (tg >= 4) { in0 += t0; in1 += t1; } }
              const float bl0 = __shfl(in0, 56 + cp), bl1 = __shfl(in1, 56 + cp), br0 = __shfl(in0, 24 + cp), br1 = __shfl(in1, 24 + cp);
              const float ex0 = in0 - x0 - br0, ex1 = in1 - x1 - br1;
#pragma unroll
              for (int i = 0; i < 8; ++i) { const int t = 8 * tg + i; const float d0 = ex0 + cum0[i], d1 = ex1 + cum1[i];
                  *(LAS unsigned*)(L + QT + off_b(t, 2 * wave + (cp >> 2)) + (cp & 3) * 4) = pk2(q0[i] * __expf(d0), q1[i] * __expf(d1));
                  *(LAS unsigned*)(L + KT + off_b(t, 2 * wave + (cp >> 2)) + (cp & 3) * 4) = pk2(kk0[i] * __expf(-d0), kk1[i] * __expf(-d1)); }
#pragma unroll
              for (int k = 0; k < 2; ++k) { const int q = tid + 512 * k, j = q >> 4, ch = q & 15; *(LAS v4u*)(L + VS + off_b(j, ch)) = pv[k]; }
              const float la0 = __shfl(bl0, 2 * fq), la1 = __shfl(bl1, 2 * fq), lb0_ = __shfl(bl0, 2 * fq + 1), lb1_ = __shfl(bl1, 2 * fq + 1);
              const float ra0 = __shfl(br0, 2 * fq), ra1 = __shfl(br1, 2 * fq), rb0 = __shfl(br0, 2 * fq + 1), rb1 = __shfl(br1, 2 * fq + 1);
              const float ebr[4] = {__expf(ra0), __expf(ra1), __expf(rb0), __expf(rb1)};
              ebl[0] = __expf(la0); ebl[1] = __expf(la1); ebl[2] = __expf(lb0_); ebl[3] = __expf(lb1_);
              ebd[0] = __expf(la0 - ra0); ebd[1] = __expf(la1 - ra1); ebd[2] = __expf(lb0_ - rb0); ebd[3] = __expf(lb1_ - rb1);
              const int kc = 16 * wave + 4 * fq;
#pragma unroll
              for (int tv = 0; tv < 8; ++tv) { const int v = 16 * tv + fr;
                  *(LAS v2u*)(L + STI + off_b(v, kc >> 3) + (kc & 4) * 2) = (v2u){pk2(Sacc[tv][0] * ebr[0], Sacc[tv][1] * ebr[1]), pk2(Sacc[tv][2] * ebr[2], Sacc[tv][3] * ebr[3])}; } }
            __syncthreads();
            if (s + 1 < s_begin + GSTEPS) H2_ISSUE(s + 1);
#pragma unroll
            for (int tt = 0; tt < 2; ++tt) { const int t = 2 * wave + tt, ts = t >> 2, ti = t & 3;
                pg8::f32x4 acc = {0.f, 0.f, 0.f, 0.f};
                if (ts <= ti) {
#pragma unroll
                    for (int ks = 0; ks < 4; ++ks) { const bf16x8 fa = *(const LAS bf16x8*)(L + KT + off_b(16 * ts + fr, 4 * ks + fq)), fb = *(const LAS bf16x8*)(L + QT + off_b(16 * ti + fr, 4 * ks + fq));
                        acc = __builtin_amdgcn_mfma_f32_16x16x32_bf16(fa, fb, acc, 0, 0, 0); } }
                const int i = 16 * ti + fr, j0 = 16 * ts + 4 * fq; float o[4];
#pragma unroll
                for (int e = 0; e < 4; ++e) o[e] = (j0 + e <= i) ? acc[e] : 0.f;
                *(LAS v2u*)(L + AI + off64(i, j0 >> 3) + (j0 & 4) * 2) = (v2u){pk2(o[0], o[1]), pk2(o[2], o[3])}; }
            pg8::f32x4 oacc[4];
#pragma unroll
            for (int ti = 0; ti < 4; ++ti) oacc[ti] = (pg8::f32x4){0.f, 0.f, 0.f, 0.f};
#pragma unroll
            for (int ks = 0; ks < 4; ++ks) { const bf16x8 fa = *(const LAS bf16x8*)(L + STI + off_b(16 * wave + fr, 4 * ks + fq));
#pragma unroll
                for (int ti = 0; ti < 4; ++ti) { const bf16x8 fb = *(const LAS bf16x8*)(L + QT + off_b(16 * ti + fr, 4 * ks + fq)); oacc[ti] = __builtin_amdgcn_mfma_f32_16x16x32_bf16(fa, fb, oacc[ti], 0, 0, 0); } }
            bf16x8 vw[2];
            { bf16x8 kf[2]; tr_frag2(LB + KT + tr_addr_b(lane, wave, 0, 0), LB + KT + tr_addr_b(lane, wave, 0, 1), LB + KT + tr_addr_b(lane, wave, 1, 0), LB + KT + tr_addr_b(lane, wave, 1, 1), kf[0], kf[1]);
#pragma unroll
              for (int tv = 0; tv < 8; ++tv) { bf16x8 vf[2]; tr_frag2(LB + VS + tr_addr_b(lane, tv, 0, 0), LB + VS + tr_addr_b(lane, tv, 0, 1), LB + VS + tr_addr_b(lane, tv, 1, 0), LB + VS + tr_addr_b(lane, tv, 1, 1), vf[0], vf[1]);
                  if (tv == wave) { vw[0] = vf[0]; vw[1] = vf[1]; }
                  pg8::f32x4 p = {0.f, 0.f, 0.f, 0.f};
                  p = __builtin_amdgcn_mfma_f32_16x16x32_bf16(kf[0], vf[0], p, 0, 0, 0); p = __builtin_amdgcn_mfma_f32_16x16x32_bf16(kf[1], vf[1], p, 0, 0, 0);
#pragma unroll
                  for (int e = 0; e < 4; ++e) Sacc[tv][e] = ebl[e] * Sacc[tv][e] + ebd[e] * p[e]; } }
            __syncthreads();
#pragma unroll
            for (int ks = 0; ks < 2; ++ks)
#pragma unroll
                for (int ti = 0; ti < 4; ++ti) { const bf16x8 fb = *(const LAS bf16x8*)(L + AI + off64(16 * ti + fr, 4 * ks + fq)); oacc[ti] = __builtin_amdgcn_mfma_f32_16x16x32_bf16(vw[ks], fb, oacc[ti], 0, 0, 0); }
            if (nm >= 4) {
#pragma unroll
                for (int ti = 0; ti < 4; ++ti) { const int i = 16 * ti + fr, v0 = 16 * wave + 4 * fq; const int tok = tok0 + (dir == 0 ? i : 63 - i);
                    *(GAS v2u*)(Oout + (size_t)tok * 1024 + h * 128 + v0) = (v2u){pk2(oacc[ti][0], oacc[ti][1]), pk2(oacc[ti][2], oacc[ti][3])}; } }
        }
#undef H2_ISSUE
    }
}
constexpr int NPH = 16;
#ifndef REPP
#define REPP -1
#endif
#define NREP(k) ((REPP) == (k) ? 2 : 1)
__global__ void __launch_bounds__(NTHR, 2) mk_fwd(Args args) {
    extern __shared__ __attribute__((aligned(16))) unsigned char lds[];
    Frame F;
    F.lds = (LAS unsigned char*)lds; F.MISC = (volatile LAS unsigned*)(F.lds + MISC_OFF);
    F.tid = threadIdx.x; F.lane = F.tid & 63; F.wave = __builtin_amdgcn_readfirstlane(F.tid >> 6);
    F.G = gridDim.x; { const int bx = blockIdx.x; F.vcu = (F.G % 8 == 0) ? (bx % 8) * (F.G / 8) + bx / 8 : bx; }
    F.ws = args.ws; F.out = args.out; F.dob = (unsigned char*)args.out; F.ctl = (gu32*)(args.ws + WS_CTL);
    F.x = args.in[0]; F.c = args.in[1]; F.ctx = args.in[2]; F.c_ctx = args.in[3]; F.w_ada = args.in[4]; F.b_ada = args.in[5]; F.norm_g = args.in[6]; F.w_in = args.in[7];
    F.conv_w = args.in[8]; F.a_log = args.in[9]; F.dt_bias = args.in[10]; F.gdn_nw = args.in[11]; F.lb_logits = args.in[12]; F.hgrn_nw = args.in[13]; F.w_ba = args.in[14];
    F.w_bb = args.in[15]; F.w_out = args.in[16]; F.w1 = args.in[17]; F.w2 = args.in[18];
    for (int u = F.tid; u < (LDS_BYTES - MISC_OFF) / 4; u += NTHR) ((LAS unsigned*)(F.lds + MISC_OFF))[u] = 0u;
    __syncthreads();
    XcdBarrier bar = xcd_barrier_post((unsigned*)(F.ctl + CW_BAR) + args.li * XCD_BAR_WORDS, F.MISC + 8);
    const int lo = args.ph_lo, hi = args.ph_hi;
#define IN(k) (lo <= (k) && (k) < hi)
#define SEAM(k) do { if ((k) + 1 < hi) xcd_barrier(bar); } while (0)
    bf16* H = (bf16*)(F.dob + DO_H); bf16* WinT = (bf16*)(F.dob + DO_WIN);
    if (IN(0)) { p0_prologue(F); SEAM(0); }
    if (IN(1)) { p1_hrows(F); SEAM(1); }
    if (IN(2)) {
        pg8::Gemm g{H, WinT + (size_t)R_QKV * D, MR, N_G1, D}; pg8::StaticOrder S; S.init(MR, N_G1, F.G, (int)blockIdx.x);
        EpiG1 E{(bf16*)(F.ws + WS_ZQ), (float*)(F.ws + WS_LA), (float*)(F.ws + WS_BE), F.a_log, F.dt_bias};
        pg8::gemm_phase<EpiG1, pg8::StaticOrder, true, true>(F.lds, g, S, E);
        SEAM(2);
    }
    if (IN(3)) { for (int rep = 0; rep < NREP(3); ++rep) p3_gdn_prep(F); SEAM(3); }
    if (IN(4)) { for (int rep = 0; rep < NREP(4); ++rep) p4_gdn_scan(F); SEAM(4); }
    if (IN(5)) { combine_norm(F, (const bf16*)(F.ws + WS_OAF), (const bf16*)(F.ws + WS_OAB), F.gdn_nw, (bf16*)(F.ws + WS_NA)); }
    if (IN(6)) {
        pg8::Gemm g{H, WinT + (size_t)R_G2 * D, MR, N_G2, D}; pg8::StaticOrder S; S.init(MR, N_G2, F.G, (int)blockIdx.x);
        EpiStore E{(bf16*)(F.ws + WS_ZH), N_G2};
        pg8::gemm_phase<EpiStore, pg8::StaticOrder, true, true>(F.lds, g, S, E);
        SEAM(6);
    }
    if (IN(7)) { for (int rep = 0; rep < NREP(7); ++rep) p7_hgrn_scan2(F, bar); SEAM(7); }
    if (IN(8)) { combine_norm(F, (const bf16*)(F.ws + WS_OBF), (const bf16*)(F.ws + WS_OBB), F.hgrn_nw, (bf16*)(F.ws + WS_NB)); w2_transpose(F); SEAM(8); }
    bf16* WaT = (bf16*)(F.ws + WS_WSM); bf16* WbT = WaT + (size_t)D * D; bf16* WoT = WbT + (size_t)D * D; bf16* W1T = WoT + (size_t)D * D;
    if (IN(9)) {
        pg8::Gemm g{H, WinT + (size_t)R_GA * D, ML, N_G3, D}; pg8::StaticOrder S; S.init(ML, N_G3, F.G, (int)blockIdx.x);
        EpiG3 E{F.ws};
        pg8::gemm_phase<EpiG3, pg8::StaticOrder, true, true>(F.lds, g, S, E);
        SEAM(9);
    }
    if (IN(10)) {
        pg8::StaticOrder S; S.init(ML, D, F.G, (int)blockIdx.x);
        { pg8::Gemm g{(const bf16*)(F.ws + WS_NA), WaT, ML, D, D}; EpiMerge<0> E{(const bf16*)(F.ws + WS_SG), (float*)(F.ws + WS_TMP), (bf16*)(F.ws + WS_MB)};
          pg8::gemm_phase<EpiMerge<0>, pg8::StaticOrder, true, true>(F.lds, g, S, E); }
        __syncthreads();
        { pg8::Gemm g{(const bf16*)(F.ws + WS_NB), WbT, ML, D, D}; EpiMerge<1> E{(const bf16*)(F.ws + WS_SG), (float*)(F.ws + WS_TMP), (bf16*)(F.ws + WS_MB)};
          pg8::gemm_phase<EpiMerge<1>, pg8::StaticOrder, true, true>(F.lds, g, S, E); }
        SEAM(10);
    }
    if (IN(11)) {
        pg8::Gemm g{(const bf16*)(F.ws + WS_MB), WoT, ML, D, D}; pg8::StaticOrder S; S.init(ML, D, F.G, (int)blockIdx.x);
        EpiF32S E{(float*)(F.ws + WS_TMP), D};
        pg8::gemm_phase<EpiF32S, pg8::StaticOrder, true, true>(F.lds, g, S, E);
        SEAM(11);
    }
    if (IN(12)) { rowwise_resid(F, F.x, (const float*)(F.ws + WS_TMP), F.norm_g + D, 2 * D, F.out, (bf16*)(F.ws + WS_H2), F.norm_g + 2 * D, 3 * D, 4 * D); SEAM(12); }
    if (IN(13)) {
        pg8::Gemm g{(const bf16*)(F.ws + WS_H2), W1T, ML, FF, D}; pg8::StaticOrder S; S.init(ML, FF, F.G, (int)blockIdx.x);
        EpiRelu2 E{(bf16*)(F.ws + WS_HID), FF};
        pg8::gemm_phase<EpiRelu2, pg8::StaticOrder, true, true>(F.lds, g, S, E);
        SEAM(13);
    }
    if (IN(14)) {
        pg8::Gemm g{(const bf16*)(F.ws + WS_HID), (const bf16*)(F.ws + WS_W2T), ML, D, FF}; pg8::StaticOrder S; S.init(ML, D, F.G, (int)blockIdx.x);
        EpiF32S E{(float*)(F.ws + WS_TMP), D};
        pg8::gemm_phase<EpiF32S, pg8::StaticOrder, true, true>(F.lds, g, S, E);
        SEAM(14);
    }
    if (IN(15)) { rowwise_resid(F, F.out, (const float*)(F.ws + WS_TMP), F.norm_g + 3 * D, 5 * D, F.out, nullptr, nullptr, 0, 0); }
#undef IN
#undef SEAM
}
}
static int fk_grid(hipStream_t) {
    static int grid = 0;
    if (grid == 0) {
        int dev = 0, cus = 0, per_cu = 0;
        if (hipGetDevice(&dev) != hipSuccess || hipDeviceGetAttribute(&cus, hipDeviceAttributeMultiprocessorCount, dev) != hipSuccess) { grid = -1; return grid; }
        if (hipFuncSetAttribute((const void*)fk::mk_fwd, hipFuncAttributeMaxDynamicSharedMemorySize, fk::LDS_BYTES) != hipSuccess) { fprintf(stderr, "hipFuncSetAttribute failed\n"); grid = -1; return grid; }
        if (hipOccupancyMaxActiveBlocksPerMultiprocessor(&per_cu, (const void*)fk::mk_fwd, fk::NTHR, fk::LDS_BYTES) != hipSuccess || per_cu < 1) { fprintf(stderr, "occupancy query: %d blocks/CU\n", per_cu); (void)hipGetLastError(); grid = -1; return grid; }
        grid = cus;
    }
    return grid;
}
static void fk_launch(const fk::Args& a0, int lo, int hi, int li, int grid, hipStream_t stream) {
    fk::Args a = a0; a.ph_lo = lo; a.ph_hi = hi; a.li = li; a.pad = 0;
    hipLaunchKernelGGL(fk::mk_fwd, dim3(grid), dim3(fk::NTHR), fk::LDS_BYTES, stream, a);
}
extern "C" void kernel_launch(void* const* d_in, const int* in_sizes, int n_in, void* d_out, int out_size, void* d_ws, size_t ws_size, hipStream_t stream) {
    const Ins I = get_ins(d_in); float* out = (float*)d_out; char* ws = (char*)d_ws;
    if (n_in != 19 || ws_size < fk::WS_END || out_size != fk::ML * fk::D) { fprintf(stderr, "kernel_launch: unexpected sizes\n"); return; }
#if MODE == 0
    OB B; if (!ob_carve(B, ws, ws_size)) return;
    oracle_pre(B, I, stream);
    for (int b = 0; b < nv::NB; ++b) oracle_batch(B, b, 99, I, out, stream);
#else
    const int grid = fk_grid(stream); if (grid < 0) return;
    (void)hipMemsetAsync(ws + fk::WS_CTL, 0, fk::CTL_ZERO_BYTES, stream);
    fk::Args a{}; for (int i = 0; i < 19; ++i) a.in[i] = (const float*)d_in[i]; a.out = out; a.ws = (unsigned char*)d_ws;
#if MODE == 2
    fk_launch(a, 0, fk::NPH, 0, grid, stream);
#elif MODE == 3
    for (int p = 0; p < fk::NPH; ++p) fk_launch(a, p, p + 1, p, grid, stream);
#else
    float* err = (float*)(ws + fk::WS_CTL) + fk::CW_ERR; int nerr = 0;
    const int MiB = 1 << 20;
#if DBG_STAGE == 1
    for (int p = 0; p < 3; ++p) fk_launch(a, p, p + 1, p, grid, stream);
    { OB B; if (!ob_carve(B, ws + (size_t)106 * MiB, (size_t)150 * MiB, 1)) { fprintf(stderr, "carve\n"); return; }
      oracle_pre(B, I, stream);
      for (int b = 0; b < nv::NB; ++b) { oracle_batch(B, b, 1, I, out, stream);
        hipLaunchKernelGGL(nv::k_cmp<unsigned short>, dim3(1024), dim3(256), 0, stream, (const unsigned short*)(ws + fk::WS_ZQ), 3072, 0, B.zbuf, 3072, b, 0, nv::ROWS, 3072, 0, err + 0);
        hipLaunchKernelGGL(nv::k_cmp<float>, dim3(64), dim3(256), 0, stream, (const float*)(ws + fk::WS_LA), 16, 0, B.la, 16, b, 0, nv::ROWS, 16, 0, err + 2);
        hipLaunchKernelGGL(nv::k_cmp<float>, dim3(64), dim3(256), 0, stream, (const float*)(ws + fk::WS_BE), 16, 0, B.be, 16, b, 0, nv::ROWS, 16, 0, err + 4); }
      nerr = 3; }
#endif
#if DBG_STAGE == 2
    for (int p = 0; p < 4; ++p) fk_launch(a, p, p + 1, p, grid, stream);
    { OB B{}; char* dob = (char*)d_out;
      B.hb = (float*)dob; B.zab = (float*)(dob + (size_t)17 * MiB); B.la = (float*)(dob + (size_t)18 * MiB); B.be = (float*)(dob + (size_t)19 * MiB); B.mod = (float*)(dob + (size_t)20 * MiB); B.lb = (float*)(dob + (size_t)21 * MiB);
      B.zbuf = (float*)(ws + (size_t)4 * MiB); B.qkvc = (float*)(ws + (size_t)55 * MiB);
      oracle_pre(B, I, stream);
      for (int b = 0; b < nv::NB; ++b) { oracle_batch(B, b, 2, I, out, stream);
        hipLaunchKernelGGL(nv::k_cmp<unsigned short>, dim3(1024), dim3(256), 0, stream, (const unsigned short*)(ws + fk::WS_QKVC), 3072, 0, B.qkvc, 3072, b, 0, nv::ROWS, 3072, 0, err + 0); }
      nerr = 1; }
#endif
#if DBG_STAGE == 3
    for (int p = 0; p < 5; ++p) fk_launch(a, p, p + 1, p, grid, stream);
    { OB B; if (!ob_carve(B, ws + (size_t)68 * MiB, (size_t)188 * MiB, 3)) { fprintf(stderr, "carve\n"); return; }
      oracle_pre(B, I, stream);
      for (int b = 0; b < nv::NB; ++b) { oracle_batch(B, b, 3, I, out, stream);
        hipLaunchKernelGGL(nv::k_cmp2, dim3(1024), dim3(256), 0, stream, (const unsigned short*)(ws + fk::WS_OAF), (const unsigned short*)(ws + fk::WS_OAB), 1024, B.oa, 1024, b, nv::T, 1024, err + 0); }
      nerr = 1; }
#endif
#if DBG_STAGE == 4
    for (int p = 0; p < 8; ++p) fk_launch(a, p, p + 1, p, grid, stream);
    { OB B; if (!ob_carve(B, ws + (size_t)100 * MiB, (size_t)156 * MiB, 4)) { fprintf(stderr, "carve\n"); return; }
      oracle_pre(B, I, stream);
      for (int b = 0; b < nv::NB; ++b) { oracle_batch(B, b, 4, I, out, stream);
        hipLaunchKernelGGL(nv::k_cmp2, dim3(1024), dim3(256), 0, stream, (const unsigned short*)(ws + fk::WS_OBF), (const unsigned short*)(ws + fk::WS_OBB), 1024, B.ob, 1024, b, nv::T, 1024, err + 0); }
      nerr = 1; }
#endif
    { OB B; if (!ob_carve(B, ws + (size_t)1 * MiB, ws_size - (size_t)1 * MiB)) { fprintf(stderr, "carve2\n"); return; }
      oracle_pre(B, I, stream);
      for (int b = 0; b < nv::NB; ++b) oracle_batch(B, b, 99, I, out, stream);
      hipLaunchKernelGGL(nv::k_scale_out, dim3(2048), dim3(256), 0, stream, out, (size_t)fk::ML * fk::D, err, nerr); }
#endif
#endif
}
```

```cpp
#include <hip/hip_runtime.h>
#include <stdint.h>
#include <stddef.h>
#include <cstdio>
#ifndef MODE
#define MODE 2
#endif
#ifndef DBG_STAGE
#define DBG_STAGE 4
#endif
namespace nv {
constexpr int D = 1024, T = 4096, CT = 256, NB = 4, H = 8, DK = 128, INT = 11296, ROWS = CT + T, FF = 4096;
constexpr float EPS = 1e-6f;
constexpr int C_QKV = 0, C_GA = 3072, C_AIN = 4096, C_BIN = 4112, C_FIN = 4128, C_QB = 6176, C_IB = 7200, C_GB = 8224, C_MG = 9248;

__device__ __forceinline__ float sigm(float x) { return 1.f / (1.f + expf(-x)); }
__device__ __forceinline__ float siluf(float x) { return x / (1.f + expf(-x)); }
__device__ __forceinline__ float softplusf(float x) { return fmaxf(x, 0.f) + log1pf(expf(-fabsf(x))); }

__device__ __forceinline__ float block_sum256(float v, float* red) {
#pragma unroll
    for (int o = 32; o >= 1; o >>= 1) v += __shfl_xor(v, o);
    const int w = threadIdx.x >> 6;
    __syncthreads();
    if ((threadIdx.x & 63) == 0) red[w] = v;
    __syncthreads();
    return red[0] + red[1] + red[2] + red[3];
}

__global__ __launch_bounds__(256) void k_mod(const float* c, const float* c_ctx, const float* w_ada, const float* b_ada, float* mod) {
    __shared__ float s[5][D];
    for (int i = threadIdx.x; i < 5 * D; i += 256) { const int r = i / D, k = i % D; const float x = r < 4 ? c[r * D + k] : c_ctx[k]; s[r][k] = siluf(x); }
    __syncthreads();
    const int n = blockIdx.x * 256 + threadIdx.x;
    float a0 = 0, a1 = 0, a2 = 0, a3 = 0, a4 = 0;
    for (int k = 0; k < D; ++k) { const float w = w_ada[(size_t)k * 6 * D + n]; a0 += s[0][k] * w; a1 += s[1][k] * w; a2 += s[2][k] * w; a3 += s[3][k] * w; a4 += s[4][k] * w; }
    const float b = b_ada[n];
    mod[0 * 6 * D + n] = a0 + b; mod[1 * 6 * D + n] = a1 + b; mod[2 * 6 * D + n] = a2 + b; mod[3 * 6 * D + n] = a3 + b; mod[4 * 6 * D + n] = a4 + b;
}
__global__ void k_lb(const float* logits, float* lb) {
    const int i = blockIdx.x * blockDim.x + threadIdx.x; if (i >= 2 * D) return;
    const float l0 = logits[i], l1 = logits[2 * D + i], m = fmaxf(l0, l1), e0 = expf(l0 - m), e1 = expf(l1 - m);
    lb[i] = e0 / (e0 + e1);
}
__global__ __launch_bounds__(256) void k_rms_mod(const float* in, float* out, const float* g, const float* modrow, int sh_off, int sc_off) {
    __shared__ float red[4];
    const float* x = in + (size_t)blockIdx.x * D; float* o = out + (size_t)blockIdx.x * D;
    float v[4], ss = 0;
#pragma unroll
    for (int j = 0; j < 4; ++j) { v[j] = x[threadIdx.x + 256 * j]; ss += v[j] * v[j]; }
    const float tot = block_sum256(ss, red), inv = 1.0f / sqrtf(tot / D + EPS);
#pragma unroll
    for (int j = 0; j < 4; ++j) { const int n = threadIdx.x + 256 * j; o[n] = (v[j] * inv * g[n]) * (1.f + modrow[sc_off + n]) + modrow[sh_off + n]; }
}
__global__ __launch_bounds__(256) void k_gemm(const float* A, int lda, const float* B, int ldb, float* C, int ldc, int M, int N, int K) {
    __shared__ float As[16][128 + 4];
    __shared__ float Bs[16][64 + 4];
    const int tx = threadIdx.x & 15, ty = threadIdx.x >> 4, m0 = blockIdx.y * 128, n0 = blockIdx.x * 64;
    float acc[8][4];
#pragma unroll
    for (int i = 0; i < 8; ++i)
#pragma unroll
        for (int j = 0; j < 4; ++j) acc[i][j] = 0.f;
    for (int k0 = 0; k0 < K; k0 += 16) {
#pragma unroll
        for (int i = 0; i < 8; ++i) { const int idx = threadIdx.x + i * 256, m = idx >> 4, k = idx & 15; As[k][m] = (m0 + m < M) ? A[(size_t)(m0 + m) * lda + k0 + k] : 0.f; }
#pragma unroll
        for (int i = 0; i < 4; ++i) { const int idx = threadIdx.x + i * 256, k = idx >> 6, n = idx & 63; Bs[k][n] = (n0 + n < N) ? B[(size_t)(k0 + k) * ldb + n0 + n] : 0.f; }
        __syncthreads();
#pragma unroll
        for (int k = 0; k < 16; ++k) {
            float a[8], b[4];
#pragma unroll
            for (int i = 0; i < 8; ++i) a[i] = As[k][ty * 8 + i];
#pragma unroll
            for (int j = 0; j < 4; ++j) b[j] = Bs[k][tx * 4 + j];
#pragma unroll
            for (int i = 0; i < 8; ++i)
#pragma unroll
                for (int j = 0; j < 4; ++j) acc[i][j] += a[i] * b[j];
        }
        __syncthreads();
    }
#pragma unroll
    for (int i = 0; i < 8; ++i)
#pragma unroll
        for (int j = 0; j < 4; ++j) { const int m = m0 + ty * 8 + i, n = n0 + tx * 4 + j; if (m < M && n < N) C[(size_t)m * ldc + n] = acc[i][j]; }
}
__global__ void k_conv(const float* zq, const float* w, float* out) {
    const size_t i = (size_t)blockIdx.x * blockDim.x + threadIdx.x; if (i >= (size_t)ROWS * 3072) return;
    const int row = (int)(i / 3072), ch = (int)(i % 3072);
    float y = 0.f;
    if (row < CT) {
#pragma unroll
        for (int j = 0; j < 3; ++j) { const int t = row + j - 1; if (t >= 0 && t < CT) y += w[(1 * 3 + j) * 3072 + ch] * zq[(size_t)t * 3072 + ch]; }
    } else {
        const int t = row - CT, r = t >> 6, c = t & 63;
#pragma unroll
        for (int dy = 0; dy < 3; ++dy)
#pragma unroll
            for (int dx = 0; dx < 3; ++dx) { const int rr = r + dy - 1, cc = c + dx - 1; if (rr >= 0 && rr < 64 && cc >= 0 && cc < 64) y += w[(dy * 3 + dx) * 3072 + ch] * zq[(size_t)(CT + rr * 64 + cc) * 3072 + ch]; }
    }
    out[i] = siluf(y);
}
__global__ __launch_bounds__(256) void k_l2n(float* qkvc) {
    const int gw = blockIdx.x * 4 + (threadIdx.x >> 6), lane = threadIdx.x & 63; if (gw >= ROWS * 16) return;
    const int row = gw >> 4, hh = gw & 15;
    float* p = qkvc + (size_t)row * 3072 + hh * 128;
    const float a = p[lane], b = p[lane + 64]; float s = a * a + b * b;
#pragma unroll
    for (int o = 32; o >= 1; o >>= 1) s += __shfl_xor(s, o);
    const float inv = (1.0f / sqrtf(s + EPS)) * (hh < 8 ? 0.08838834764831845f : 1.0f);
    p[lane] = a * inv; p[lane + 64] = b * inv;
}
__global__ void k_gates(const float* zab, const float* a_log, const float* dt_bias, float* la, float* be) {
    const int i = blockIdx.x * blockDim.x + threadIdx.x; if (i >= ROWS * 16) return;
    const int row = i >> 4, j = i & 15;
    la[i] = -expf(a_log[j]) * softplusf(zab[row * 32 + j] + dt_bias[j]);
    be[i] = sigm(zab[row * 32 + 16 + j]);
}
__global__ __launch_bounds__(128) void k_gdn_scan(const float* qkvc, const float* la, const float* be, float* o) {
    const int h = blockIdx.x & 7, dir = blockIdx.x >> 3, v = threadIdx.x;
    __shared__ float sq[2][128], sk[2][128];
    float S[128];
#pragma unroll
    for (int k = 0; k < 128; ++k) S[k] = 0.f;
    for (int s = 0; s < ROWS; ++s) {
        const int row = dir == 0 ? s : (s < CT ? CT - 1 - s : ROWS - 1 - (s - CT));
        const float* r = qkvc + (size_t)row * 3072 + h * 128; const int buf = s & 1;
        sq[buf][v] = r[v]; sk[buf][v] = r[1024 + v]; const float vv = r[2048 + v];
        const float a = expf(la[row * 16 + dir * 8 + h]), b = be[row * 16 + dir * 8 + h];
        __syncthreads();
        float ks = 0.f;
#pragma unroll
        for (int k = 0; k < 128; ++k) ks += sk[buf][k] * S[k];
        const float delta = b * (vv - a * ks); float ov = 0.f;
#pragma unroll
        for (int k = 0; k < 128; ++k) { S[k] = a * S[k] + sk[buf][k] * delta; ov += sq[buf][k] * S[k]; }
        if (row >= CT) atomicAdd(&o[(size_t)(row - CT) * 1024 + h * 128 + v], ov);
    }
}
__global__ __launch_bounds__(128) void k_hgrn_scan(const float* zh, const float* lb, float* o) {
    const int h = blockIdx.x & 7, dir = blockIdx.x >> 3, v = threadIdx.x;
    __shared__ float sq[2][128], sk[2][128], sf[2][128];
    const float lbv = lb[dir * 1024 + h * 128 + v];
    float S[128];
#pragma unroll
    for (int k = 0; k < 128; ++k) S[k] = 0.f;
    for (int s = 0; s < ROWS; ++s) {
        const int row = dir == 0 ? s : (s < CT ? CT - 1 - s : ROWS - 1 - (s - CT));
        const float* r = zh + (size_t)row * 4096; const int buf = s & 1;
        const float fz = r[dir * 1024 + h * 128 + v];
        sf[buf][v] = lbv + (1.f - lbv) * sigm(fz); sk[buf][v] = (1.f - lbv) * sigm(-fz);
        sq[buf][v] = siluf(r[2048 + h * 128 + v]) * 0.08838834764831845f; const float vv = r[3072 + h * 128 + v];
        __syncthreads();
        float ov = 0.f;
#pragma unroll
        for (int k = 0; k < 128; ++k) { S[k] = sf[buf][k] * S[k] + sk[buf][k] * vv; ov += sq[buf][k] * S[k]; }
        if (row >= CT) atomicAdd(&o[(size_t)(row - CT) * 1024 + h * 128 + v], ov);
    }
}
__global__ __launch_bounds__(256) void k_mixer_y(const float* o, const float* g, int ldg, const float* w, float* y) {
    const int gw = blockIdx.x * 4 + (threadIdx.x >> 6), lane = threadIdx.x & 63; if (gw >= T * 8) return;
    const int t = gw >> 3, h = gw & 7;
    const float* p = o + (size_t)t * 1024 + h * 128; const float a = p[lane], b = p[lane + 64]; float s = a * a + b * b;
#pragma unroll
    for (int off = 32; off >= 1; off >>= 1) s += __shfl_xor(s, off);
    const float inv = 1.0f / sqrtf(s / 128.f + EPS);
    const float* gp = g + (size_t)t * ldg + h * 128; float* yp = y + (size_t)t * 1024 + h * 128;
    yp[lane] = (a * inv * w[lane]) * siluf(gp[lane]); yp[lane + 64] = (b * inv * w[lane + 64]) * siluf(gp[lane + 64]);
}
__global__ void k_merge(const float* pa, const float* pb, const float* mg, float* m) {
    const size_t i = (size_t)blockIdx.x * blockDim.x + threadIdx.x; if (i >= (size_t)T * D) return;
    const size_t t = i / D; const int n = (int)(i % D);
    m[i] = sigm(mg[t * 2048 + n]) * pa[i] + sigm(mg[t * 2048 + 1024 + n]) * pb[i];
}
__global__ __launch_bounds__(256) void k_resid(const float* xin, const float* r, const float* g, const float* modrow, int gt_off, float* xo) {
    __shared__ float red[4];
    const size_t base = (size_t)blockIdx.x * D;
    float v[4], ss = 0;
#pragma unroll
    for (int j = 0; j < 4; ++j) { v[j] = r[base + threadIdx.x + 256 * j]; ss += v[j] * v[j]; }
    const float tot = block_sum256(ss, red), inv = 1.0f / sqrtf(tot / D + EPS);
#pragma unroll
    for (int j = 0; j < 4; ++j) { const int n = threadIdx.x + 256 * j; xo[base + n] = xin[base + n] + modrow[gt_off + n] * (v[j] * inv * g[n]); }
}
__global__ void k_relu2(float* p, size_t n) { const size_t i = (size_t)blockIdx.x * blockDim.x + threadIdx.x; if (i < n) { const float x = fmaxf(p[i], 0.f); p[i] = x * x; } }
}

struct Ins {
    const float *x, *c, *ctx, *c_ctx, *w_ada, *b_ada, *norm_g, *w_in, *conv_w, *a_log, *dt_bias, *gdn_nw, *lb_logits, *hgrn_nw, *w_ba, *w_bb, *w_out, *w1, *w2;
};
static inline Ins get_ins(void* const* d_in) {
    Ins I; const float** p = (const float**)&I; for (int i = 0; i < 19; ++i) p[i] = (const float*)d_in[i]; return I;
}
static inline void nv_gemm(const float* A, int lda, const float* B, int ldb, float* C, int ldc, int M, int N, int K, hipStream_t s) {
    dim3 grid((N + 63) / 64, (M + 127) / 128);
    hipLaunchKernelGGL(nv::k_gemm, grid, dim3(256), 0, s, A, lda, B, ldb, C, ldc, M, N, K);
}
struct OB { float *mod, *lb, *hb, *zab, *la, *be, *zbuf, *qkvc, *oa, *ob, *ya, *yb, *mbuf, *rbuf; };
static inline bool ob_carve(OB& B, char* base, size_t avail, int stop = 99) {
    using namespace nv; size_t off = 0;
    auto carve = [&](size_t bytes) { float* p = (float*)(base + off); off += (bytes + 255) & ~(size_t)255; return p; };
    B.mod = carve(5 * 6 * D * 4); B.lb = carve(2 * D * 4);
    B.hb = carve((size_t)ROWS * D * 4);
    B.zab = carve((size_t)ROWS * 32 * 4); B.la = carve((size_t)ROWS * 16 * 4); B.be = carve((size_t)ROWS * 16 * 4);
    B.oa = carve((size_t)T * D * 4); B.ob = carve((size_t)T * D * 4);
    B.zbuf = carve((size_t)ROWS * 4096 * 4); if (stop == 1 || stop == 4) return off <= avail;
    B.qkvc = carve((size_t)ROWS * 3072 * 4); if (stop == 2 || stop == 3) return off <= avail;
    B.ya = carve((size_t)T * D * 4); B.yb = carve((size_t)T * D * 4);
    B.mbuf = carve((size_t)T * D * 4); B.rbuf = carve((size_t)T * D * 4);
    return off <= avail;
}
static void oracle_pre(const OB& B, const Ins& I, hipStream_t stream) {
    using namespace nv;
    hipLaunchKernelGGL(k_mod, dim3(6 * D / 256), dim3(256), 0, stream, I.c, I.c_ctx, I.w_ada, I.b_ada, B.mod);
    hipLaunchKernelGGL(k_lb, dim3(2 * D / 256), dim3(256), 0, stream, I.lb_logits, B.lb);
}
static void oracle_batch(const OB& B, int b, int stop, const Ins& I, float* out, hipStream_t stream) {
    using namespace nv;
    const float* xb = I.x + (size_t)b * T * D; const float* cb = I.ctx + (size_t)b * CT * D; float* outb = out + (size_t)b * T * D;
    const float* modb = B.mod + (size_t)b * 6 * D; const float* modc = B.mod + (size_t)4 * 6 * D;
    float *hb = B.hb, *zbuf = B.zbuf, *qkvc = B.qkvc, *zab = B.zab, *la = B.la, *be = B.be, *oa = B.oa, *ob = B.ob, *ya = B.ya, *yb = B.yb, *mbuf = B.mbuf, *rbuf = B.rbuf;
    hipLaunchKernelGGL(k_rms_mod, dim3(CT), dim3(256), 0, stream, cb, hb, I.norm_g, modc, 0, D);
    hipLaunchKernelGGL(k_rms_mod, dim3(T), dim3(256), 0, stream, xb, hb + (size_t)CT * D, I.norm_g, modb, 0, D);
    if (stop != 4) {
        nv_gemm(hb, D, I.w_in + C_QKV, INT, zbuf, 3072, ROWS, 3072, D, stream);
        nv_gemm(hb, D, I.w_in + C_AIN, INT, zab, 32, ROWS, 32, D, stream);
        hipLaunchKernelGGL(k_gates, dim3(ROWS * 16 / 256), dim3(256), 0, stream, zab, I.a_log, I.dt_bias, la, be);
        if (stop == 1) return;
        hipLaunchKernelGGL(k_conv, dim3((unsigned)(((size_t)ROWS * 3072 + 255) / 256)), dim3(256), 0, stream, zbuf, I.conv_w, qkvc);
        hipLaunchKernelGGL(k_l2n, dim3(ROWS * 16 / 4), dim3(256), 0, stream, qkvc);
        if (stop == 2) return;
        (void)hipMemsetAsync(oa, 0, (size_t)T * D * 4, stream);
        hipLaunchKernelGGL(k_gdn_scan, dim3(16), dim3(128), 0, stream, qkvc, la, be, oa);
        if (stop == 3) return;
    }
    nv_gemm(hb, D, I.w_in + C_FIN, INT, zbuf, 4096, ROWS, 4096, D, stream);
    (void)hipMemsetAsync(ob, 0, (size_t)T * D * 4, stream);
    hipLaunchKernelGGL(k_hgrn_scan, dim3(16), dim3(128), 0, stream, zbuf, B.lb, ob);
    if (stop == 4) return;
    float* zga = zbuf; float* zgb = zbuf + (size_t)T * D; float* zmg = zbuf + (size_t)2 * T * D;
    const float* hl = hb + (size_t)CT * D;
    nv_gemm(hl, D, I.w_in + C_GA, INT, zga, D, T, D, D, stream);
    nv_gemm(hl, D, I.w_in + C_GB, INT, zgb, D, T, D, D, stream);
    nv_gemm(hl, D, I.w_in + C_MG, INT, zmg, 2 * D, T, 2 * D, D, stream);
    hipLaunchKernelGGL(k_mixer_y, dim3(T * 8 / 4), dim3(256), 0, stream, oa, zga, D, I.gdn_nw, ya);
    hipLaunchKernelGGL(k_mixer_y, dim3(T * 8 / 4), dim3(256), 0, stream, ob, zgb, D, I.hgrn_nw, yb);
    if (stop == 5) return;
    float* pa = qkvc; float* pb = qkvc + (size_t)T * D;
    nv_gemm(ya, D, I.w_ba, D, pa, D, T, D, D, stream);
    nv_gemm(yb, D, I.w_bb, D, pb, D, T, D, D, stream);
    hipLaunchKernelGGL(k_merge, dim3(T * D / 256), dim3(256), 0, stream, pa, pb, zmg, mbuf);
    if (stop == 6) return;
    nv_gemm(mbuf, D, I.w_out, D, rbuf, D, T, D, D, stream);
    hipLaunchKernelGGL(k_resid, dim3(T), dim3(256), 0, stream, xb, rbuf, I.norm_g + D, modb, 2 * D, outb);
    hipLaunchKernelGGL(k_rms_mod, dim3(T), dim3(256), 0, stream, outb, ya, I.norm_g + 2 * D, modb, 3 * D, 4 * D);
    if (stop == 7) return;
    nv_gemm(ya, D, I.w1, FF, zbuf, FF, T, FF, D, stream);
    hipLaunchKernelGGL(k_relu2, dim3((unsigned)((size_t)T * FF / 256)), dim3(256), 0, stream, zbuf, (size_t)T * FF);
    nv_gemm(zbuf, FF, I.w2, D, yb, D, T, D, FF, stream);
    hipLaunchKernelGGL(k_resid, dim3(T), dim3(256), 0, stream, outb, yb, I.norm_g + 3 * D, modb, 5 * D, outb);
}
namespace nv {
__host__ __device__ inline int fast_row(int b, int r) { return r < CT ? NB * T + b * CT + r : b * T + (r - CT); }
template <typename TA> __device__ __forceinline__ float ldv(const TA* p, size_t i);
template <> __device__ __forceinline__ float ldv<float>(const float* p, size_t i) { return p[i]; }
template <> __device__ __forceinline__ float ldv<unsigned short>(const unsigned short* p, size_t i) { return __uint_as_float(((unsigned)p[i]) << 16); }
template <typename TA> __global__ void k_cmp(const TA* fast, int fld, int fcol0, const float* orc, int old, int b, int r0, int nr, int nc, int rowmode, float* err) {
    float num = 0.f, den = 0.f;
    const size_t tot = (size_t)nr * nc;
    for (size_t i = (size_t)blockIdx.x * blockDim.x + threadIdx.x; i < tot; i += (size_t)gridDim.x * blockDim.x) {
        const int r = r0 + (int)(i / nc), c = (int)(i % nc);
        const int fr = rowmode == 0 ? fast_row(b, r) : b * T + r;
        const float a = ldv<TA>(fast, (size_t)fr * fld + fcol0 + c), o = orc[(size_t)r * old + c];
        const float d = a - o; num += d * d; den += o * o;
    }
#pragma unroll
    for (int o = 32; o >= 1; o >>= 1) { num += __shfl_xor(num, o); den += __shfl_xor(den, o); }
    if ((threadIdx.x & 63) == 0) { atomicAdd(err, num); atomicAdd(err + 1, den); }
}
__global__ void k_cmp2(const unsigned short* f0, const unsigned short* f1, int fld, const float* orc, int old, int b, int nr, int nc, float* err) {
    float num = 0.f, den = 0.f;
    const size_t tot = (size_t)nr * nc;
    for (size_t i = (size_t)blockIdx.x * blockDim.x + threadIdx.x; i < tot; i += (size_t)gridDim.x * blockDim.x) {
        const int r = (int)(i / nc), c = (int)(i % nc); const size_t fi = (size_t)(b * T + r) * fld + c;
        const float a = ldv<unsigned short>(f0, fi) + ldv<unsigned short>(f1, fi), o = orc[(size_t)r * old + c];
        const float d = a - o; num += d * d; den += o * o;
    }
#pragma unroll
    for (int o = 32; o >= 1; o >>= 1) { num += __shfl_xor(num, o); den += __shfl_xor(den, o); }
    if ((threadIdx.x & 63) == 0) { atomicAdd(err, num); atomicAdd(err + 1, den); }
}
__global__ void k_scale_out(float* out, size_t n, const float* err, int nerr) {
    float e = 0.f; for (int i = 0; i < nerr; ++i) e += sqrtf(err[2 * i] / fmaxf(err[2 * i + 1], 1e-30f));
    if (!(e == e)) e = 10.f;
    if (!(e < 10.f)) e = 10.f;
    for (size_t i = (size_t)blockIdx.x * blockDim.x + threadIdx.x; i < n; i += (size_t)gridDim.x * blockDim.x) out[i] *= (1.f + e);
}
}
namespace pg8 {
#define PG8_LAS __attribute__((address_space(3)))
typedef unsigned short bf16_t;
typedef short bf16x8 __attribute__((ext_vector_type(8)));
typedef float f32x4 __attribute__((ext_vector_type(4)));
typedef unsigned u32x4 __attribute__((ext_vector_type(4)));
constexpr int BM = 256, BK = 64, HALF = 128, HTB = HALF * BK * 2  , STAGE_BYTES = 8 * HTB, NXCD = 8, WGM = 8;

__host__ __device__ __forceinline__ int lds_byte(int r, int c) { const int st = (r >> 4) * 2 + (c >> 5), rr = r & 15, cc = c & 31, ob = rr * 64 + cc * 2; return st * 1024 + (ob ^ (((ob >> 9) & 1) << 5)); }
__host__ __device__ __forceinline__ void stage_rc(int b, int& R, int& C) { const int st = b / 1024, sb = b % 1024, swz = sb ^ (((sb >> 9) & 1) << 5); R = (st >> 1) * 16 + swz / 64; C = (st & 1) * 32 + (swz % 64) / 2; }
__host__ __device__ __forceinline__ int perm32(int rho) { const int n = rho >> 4, i = rho & 15; return 8 * (i >> 2) + 4 * n + (i & 3); }

struct Unit { int pm, pn; };
struct Gemm { const bf16_t* A; const bf16_t* Bt; int M, N, K; };

struct StaticOrder {
    int nM, nN, nwg, G, c;
    __host__ __device__ void init(int M, int N, int G_, int c_) { nM = M / BM; nN = N / BM; nwg = nM * nN; G = G_; c = c_; }
    __host__ __device__ bool next(int i, Unit& u) const {
        const long L = (long)i * G + c; if (L >= nwg) return false;
        int wgid = (int)L; { const int q = nwg / NXCD, r = nwg % NXCD, xcd = wgid % NXCD, off = wgid / NXCD; wgid = (xcd < r ? xcd * (q + 1) : r * (q + 1) + (xcd - r) * q) + off; }
        const int nig = WGM * nN, gid = wgid / nig, fm = gid * WGM, gsz = (nM - fm) < WGM ? (nM - fm) : WGM;
        u.pm = fm + ((wgid % nig) % gsz); u.pn = (wgid % nig) / gsz; return true;
    }
    __device__ __forceinline__ void a_ready(const Unit&) const {}
    __device__ __forceinline__ void done(const Unit&) const {}
};

__device__ __forceinline__ unsigned cvt_pk_bf16(float lo, float hi) { unsigned r; asm volatile("v_cvt_pk_bf16_f32 %0, %1, %2" : "=v"(r) : "v"(lo), "v"(hi)); return r; }
typedef float f32x2 __attribute__((ext_vector_type(2)));
typedef float f32x2 __attribute__((ext_vector_type(2)));
template <class Epi, class Sched, bool ALIGN_EPI = false, bool SP2 = false>
__device__ __forceinline__ void gemm_phase(PG8_LAS unsigned char* lds, const Gemm g, const Sched& S, const Epi& E) {
    const int tid = threadIdx.x, wid = __builtin_amdgcn_readfirstlane(tid >> 6), lane = tid & 63, wr = wid >> 2, wc = wid & 3, fr = lane & 15, fq = lane >> 4;
    const int K = g.K, nt = K / BK;
    unsigned voffA[2], voffB[2];
#pragma unroll
    for (int i = 0; i < 2; ++i) { int R, C; stage_rc(tid * 16 + i * 8192, R, C); const int Rb = Epi::PERM ? ((R & ~31) + perm32(R & 31)) : R;
        voffA[i] = (unsigned)(R * K + C) * 2u; voffB[i] = (unsigned)(Rb * K + C) * 2u; }
    const size_t kstep = (size_t)(BK * 2);
    const size_t hstep = (size_t)HALF * K * 2;
    const size_t tstep = 2 * hstep;
    const unsigned ldsw = (unsigned)wid * 1024u;
    const int aoff = lds_byte(wr * 64 + fr, fq * 8), boff = lds_byte(wc * 32 + fr, fq * 8);
#define PG8_SA(b, h) (((b) * 2 + (h)) * HTB)
#define PG8_SB(b, h) ((4 + (b) * 2 + (h)) * HTB)
#define PG8_STAGE(bufoff, gbase, voff) do { _Pragma("unroll") for (int _i = 0; _i < 2; ++_i) \
        __builtin_amdgcn_global_load_lds((const unsigned*)((const char*)(gbase) + (voff)[_i]), (PG8_LAS unsigned*)(lds + (bufoff) + ldsw + _i * 8192), 16, 0, 0); } while (0)
#define PG8_LDA(dst, b, h) do { _Pragma("unroll") for (int m = 0; m < 4; ++m) _Pragma("unroll") for (int k = 0; k < 2; ++k) dst[m][k] = *(const PG8_LAS bf16x8*)(lds + PG8_SA(b, h) + aoff + m * 2048 + k * 1024); } while (0)
#define PG8_LDB(dst, b, h) do { _Pragma("unroll") for (int n = 0; n < 2; ++n) _Pragma("unroll") for (int k = 0; k < 2; ++k) dst[n][k] = *(const PG8_LAS bf16x8*)(lds + PG8_SB(b, h) + boff + n * 2048 + k * 1024); } while (0)
#define PG8_MMA(ai, bj, At, Bt) do { __builtin_amdgcn_s_setprio(1); _Pragma("unroll") for (int m = 0; m < 4; ++m) _Pragma("unroll") for (int n = 0; n < 2; ++n) _Pragma("unroll") for (int k = 0; k < 2; ++k) \
        acc[ai][bj][m][n] = __builtin_amdgcn_mfma_f32_16x16x32_bf16(Bt[n][k], At[m][k], acc[ai][bj][m][n], 0, 0, 0); __builtin_amdgcn_s_setprio(0); } while (0)
#define PG8_WAIT_V(n) asm volatile("s_waitcnt vmcnt(" #n ")" ::: "memory")
#define PG8_WAIT_L(n) asm volatile("s_waitcnt lgkmcnt(" #n ")" ::: "memory")
#define PG8_BAR __builtin_amdgcn_s_barrier()
#define PG8_SCHED __builtin_amdgcn_sched_barrier(0)
    Unit cur, nxt; int ui = 0;
    if (!S.next(0, cur)) return;
    f32x4 acc[2][2][4][2];
#pragma unroll
    for (int a = 0; a < 2; ++a)
#pragma unroll
        for (int b = 0; b < 2; ++b)
#pragma unroll
            for (int m = 0; m < 4; ++m)
#pragma unroll
                for (int n = 0; n < 2; ++n) acc[a][b][m][n] = (f32x4){0.f, 0.f, 0.f, 0.f};
    bf16x8 At[4][2], B0[2][2], B1[2][2];
    const char* cA = (const char*)g.A + (size_t)cur.pm * tstep; const char* cB = (const char*)g.Bt + (size_t)cur.pn * tstep;
    S.a_ready(cur);
    if constexpr (SP2) {
        PG8_STAGE(PG8_SB(0, 0), cB, voffB); PG8_STAGE(PG8_SB(0, 1), cB + hstep, voffB); PG8_STAGE(PG8_SA(0, 0), cA, voffA); PG8_STAGE(PG8_SA(0, 1), cA + hstep, voffA);
        if (wr == 1) PG8_BAR;
        PG8_WAIT_V(2); PG8_BAR;
        PG8_STAGE(PG8_SB(1, 0), cB + kstep, voffB); PG8_STAGE(PG8_SA(1, 0), cA + kstep, voffA); PG8_STAGE(PG8_SB(1, 1), cB + hstep + kstep, voffB);
        PG8_WAIT_V(6); PG8_BAR;
    } else {
        PG8_STAGE(PG8_SB(0, 0), cB, voffB); PG8_STAGE(PG8_SA(0, 0), cA, voffA); PG8_STAGE(PG8_SB(0, 1), cB + hstep, voffB); PG8_STAGE(PG8_SA(0, 1), cA + hstep, voffA);
        if (wr == 1) PG8_BAR;
        PG8_WAIT_V(4); PG8_BAR;
        PG8_STAGE(PG8_SB(1, 0), cB + kstep, voffB); PG8_STAGE(PG8_SA(1, 0), cA + kstep, voffA); PG8_STAGE(PG8_SB(1, 1), cB + hstep + kstep, voffB);
        PG8_WAIT_V(6); PG8_BAR;
    }
    for (;;) {
        const bool has_next = S.next(ui + 1, nxt);
        const char* nA = has_next ? (const char*)g.A + (size_t)nxt.pm * tstep : cA; const char* nB = has_next ? (const char*)g.Bt + (size_t)nxt.pn * tstep : cB;
        for (int t = 0; t < nt; t += 2) {
            const bool last = (t == nt - 2);
            const char* a1 = cA + (size_t)(t + 1) * kstep;
            const char* a2 = last ? nA : cA + (size_t)(t + 2) * kstep; const char* b2 = last ? nB : cB + (size_t)(t + 2) * kstep;
            const char* a3 = a2 + kstep; const char* b3 = b2 + kstep;
            if (last && has_next) S.a_ready(nxt);
            if constexpr (SP2) {
            PG8_LDB(B0, 0, 0); PG8_LDB(B1, 0, 1); PG8_SCHED; PG8_LDA(At, 0, 0); PG8_STAGE(PG8_SA(1, 1), a1 + hstep, voffA);
            PG8_WAIT_V(8); PG8_WAIT_L(0); PG8_BAR; PG8_MMA(0, 0, At, B0); PG8_MMA(0, 1, At, B1); PG8_BAR; PG8_SCHED;
            PG8_LDA(At, 0, 1); PG8_STAGE(PG8_SB(0, 0), b2, voffB); PG8_STAGE(PG8_SB(0, 1), b2 + hstep, voffB); PG8_STAGE(PG8_SA(0, 0), a2, voffA);
            PG8_WAIT_V(8); PG8_WAIT_L(0); PG8_BAR; PG8_MMA(1, 0, At, B0); PG8_MMA(1, 1, At, B1); PG8_BAR; PG8_SCHED;
            PG8_LDB(B0, 1, 0); PG8_LDB(B1, 1, 1); PG8_SCHED; PG8_LDA(At, 1, 0); PG8_STAGE(PG8_SA(0, 1), a2 + hstep, voffA);
            PG8_WAIT_V(8); PG8_WAIT_L(0); PG8_BAR; PG8_MMA(0, 0, At, B0); PG8_MMA(0, 1, At, B1); PG8_BAR; PG8_SCHED;
            PG8_LDA(At, 1, 1); PG8_STAGE(PG8_SB(1, 0), b3, voffB); PG8_STAGE(PG8_SB(1, 1), b3 + hstep, voffB); PG8_STAGE(PG8_SA(1, 0), a3, voffA);
            PG8_WAIT_V(8); PG8_WAIT_L(0); PG8_BAR; PG8_MMA(1, 0, At, B0); PG8_MMA(1, 1, At, B1); PG8_BAR; PG8_SCHED;
            } else {
            PG8_LDB(B0, 0, 0); PG8_SCHED; PG8_LDA(At, 0, 0); PG8_STAGE(PG8_SA(1, 1), a1 + hstep, voffA);
            PG8_WAIT_L(8); PG8_BAR; PG8_WAIT_L(0); PG8_MMA(0, 0, At, B0); PG8_BAR; PG8_SCHED;
            PG8_LDB(B1, 0, 1); PG8_STAGE(PG8_SB(0, 0), b2, voffB);
            PG8_BAR; PG8_WAIT_L(0); PG8_MMA(0, 1, At, B1); PG8_BAR;
            PG8_LDA(At, 0, 1); PG8_STAGE(PG8_SA(0, 0), a2, voffA);
            PG8_BAR; PG8_WAIT_L(0); PG8_MMA(1, 0, At, B0); PG8_BAR; PG8_SCHED;
            PG8_STAGE(PG8_SB(0, 1), b2 + hstep, voffB);
            PG8_WAIT_V(6); PG8_BAR; PG8_MMA(1, 1, At, B1); PG8_BAR;
            PG8_LDB(B0, 1, 0); PG8_SCHED; PG8_LDA(At, 1, 0); PG8_STAGE(PG8_SA(0, 1), a2 + hstep, voffA);
            PG8_WAIT_L(8); PG8_BAR; PG8_WAIT_L(0); PG8_MMA(0, 0, At, B0); PG8_BAR; PG8_SCHED;
            PG8_LDB(B1, 1, 1); PG8_STAGE(PG8_SB(1, 0), b3, voffB);
            PG8_BAR; PG8_WAIT_L(0); PG8_MMA(0, 1, At, B1); PG8_BAR;
            PG8_LDA(At, 1, 1); PG8_STAGE(PG8_SA(1, 0), a3, voffA);
            PG8_BAR; PG8_WAIT_L(0); PG8_MMA(1, 0, At, B0); PG8_BAR; PG8_SCHED;
            PG8_STAGE(PG8_SB(1, 1), b3 + hstep, voffB);
            PG8_WAIT_V(6); PG8_BAR; PG8_MMA(1, 1, At, B1); PG8_BAR;
            }
        }
        if constexpr (ALIGN_EPI) { if (wr == 0) PG8_BAR; }
        if constexpr (!Epi::AFTER_DRAIN) { E(acc, cur, wr, wc, fr, fq); S.done(cur); }
        if (!has_next) break;
#pragma unroll
        for (int a = 0; a < 2; ++a)
#pragma unroll
            for (int b = 0; b < 2; ++b)
#pragma unroll
                for (int m = 0; m < 4; ++m)
#pragma unroll
                    for (int n = 0; n < 2; ++n) acc[a][b][m][n] = (f32x4){0.f, 0.f, 0.f, 0.f};
        cur = nxt; cA = nA; cB = nB; ++ui;
        if constexpr (ALIGN_EPI) { if (wr == 1) PG8_BAR; }
    }
    PG8_WAIT_V(0);
    if constexpr (!ALIGN_EPI) { if (wr == 0) PG8_BAR; }
    PG8_BAR;
    if constexpr (Epi::AFTER_DRAIN) { E.fused(acc, cur, wr, wc, fr, fq, lds, wid, lane); S.done(cur); }
#undef PG8_SA
#undef PG8_SB
#undef PG8_STAGE
#undef PG8_LDA
#undef PG8_LDB
#undef PG8_MMA
#undef PG8_WAIT_V
#undef PG8_WAIT_L
#undef PG8_BAR
#undef PG8_SCHED
}
}
namespace fk {
#define GAS __attribute__((address_space(1)))
#define LAS __attribute__((address_space(3)))
typedef unsigned short bf16;
typedef unsigned v4u __attribute__((ext_vector_type(4)));
typedef unsigned v2u __attribute__((ext_vector_type(2)));
typedef float f32x4 __attribute__((ext_vector_type(4)));
typedef short bf16x8 __attribute__((ext_vector_type(8)));
typedef GAS unsigned gu32;
#define RLX_AGENT __ATOMIC_RELAXED, __HIP_MEMORY_SCOPE_AGENT
#define LDS_WAIT() asm volatile("s_waitcnt lgkmcnt(0)" ::: "memory")
#define VM_WAIT() asm volatile("s_waitcnt vmcnt(0)" ::: "memory")
__device__ __forceinline__ unsigned f2bf(float f) { unsigned u = __builtin_bit_cast(unsigned, f); return (u + 0x7fffu + ((u >> 16) & 1u)) >> 16; }
typedef float f32x2_t __attribute__((ext_vector_type(2)));
typedef __bf16 bf16x2_t __attribute__((ext_vector_type(2)));
__device__ __forceinline__ unsigned pk2(float lo, float hi) { const f32x2_t v = {lo, hi}; return __builtin_bit_cast(unsigned, __builtin_convertvector(v, bf16x2_t)); }
__device__ __forceinline__ float bf2f(unsigned short b) { return __uint_as_float(((unsigned)b) << 16); }
__device__ __forceinline__ float bflo(unsigned w) { return __uint_as_float(w << 16); }
__device__ __forceinline__ float bfhi(unsigned w) { return __uint_as_float(w & 0xffff0000u); }
__device__ __forceinline__ float frcp(float x) { return __builtin_amdgcn_rcpf(x); }
__device__ __forceinline__ float sigm(float x) { return frcp(1.f + __expf(-x)); }
__device__ __forceinline__ float siluf(float x) { return x * frcp(1.f + __expf(-x)); }
__device__ __forceinline__ float softplusf(float x) { return fmaxf(x, 0.f) + log1pf(__expf(-fabsf(x))); }
__device__ __forceinline__ float wave_sum(float v) {
#pragma unroll
    for (int o = 1; o < 64; o <<= 1) v += __shfl_xor(v, o);
    return v;
}
#define XB_TMO      128
#define XB_XCNT(j)  (256  + 64 * (j))
#define XB_XSUB(j)  (1280 + 64 * (j))
#define XB_XGEN(j)  (2304 + 64 * (j))
#define XB_TOP      3328
#define XB_TOPGEN   3392
#define XCD_BAR_WORDS 3456
#define XB_SPIN_CAP (1u << 18)

__device__ __forceinline__ unsigned xb_ld(unsigned* p)              { return __hip_atomic_load(p, __ATOMIC_RELAXED, __HIP_MEMORY_SCOPE_AGENT); }
__device__ __forceinline__ unsigned xb_add(unsigned* p, unsigned v) { return __hip_atomic_fetch_add(p, v, __ATOMIC_RELAXED, __HIP_MEMORY_SCOPE_AGENT); }
__device__ __forceinline__ unsigned xb_xcc_id() { return (unsigned)__builtin_amdgcn_s_getreg((3 << 11) | 20) & 0xFu; }
#define XB_SPIN(cond, bar) do { unsigned _sp = 0; while (cond) { __builtin_amdgcn_s_sleep(1); \
    if ((++_sp & 255u) == 0u) { if (xb_ld(&(bar)[XB_TMO])) break; if (_sp > XB_SPIN_CAP) { atomicAdd(&(bar)[XB_TMO], 1u); break; } } } } while (0)

struct XcdBarrier {
    unsigned* bar; unsigned x;
    volatile LAS unsigned* st;
};

__device__ __forceinline__ XcdBarrier xcd_barrier_post(unsigned* bar, volatile LAS unsigned* st) {
    XcdBarrier b; b.bar = bar; b.x = xb_xcc_id(); b.st = st;
    if (threadIdx.x == 0) (void)xb_add(&bar[XB_XCNT(b.x)], 1u);
    return b;
}
__device__ __forceinline__ void xcd_barrier_complete(unsigned* bar, unsigned x, unsigned& nloc, unsigned& nx) {
    const unsigned G = gridDim.x * gridDim.y * gridDim.z;
    unsigned sum, cnt, mine, sp = 0u;
    for (;;) {
        sum = 0u; cnt = 0u; mine = 0u;
#pragma unroll
        for (unsigned j = 0; j < 16; ++j) { const unsigned c = xb_ld(&bar[XB_XCNT(j)]); sum += c; cnt += (c > 0u) ? 1u : 0u; mine = (j == x) ? c : mine; }
        if (sum == G) break;
        __builtin_amdgcn_s_sleep(1);
        if ((++sp & 255u) == 0u) { if (xb_ld(&bar[XB_TMO])) break; if (sp > XB_SPIN_CAP) { atomicAdd(&bar[XB_TMO], 1u); break; } }
    }
    nloc = mine > 0u ? mine : 1u; nx = cnt > 0u ? cnt : 1u;
}

__device__ __forceinline__ void xcd_barrier(const XcdBarrier& b) {
    asm volatile("s_waitcnt vmcnt(0)" ::: "memory");
    __syncthreads();
    if (threadIdx.x == 0) {
        unsigned* bar = b.bar;
        __builtin_amdgcn_s_waitcnt(0);
        unsigned nloc = b.st[0], nx = b.st[1];
        if (nloc == 0u) { xcd_barrier_complete(bar, b.x, nloc, nx); b.st[0] = nloc; b.st[1] = nx; }
        const unsigned old = xb_add(&bar[XB_XSUB(b.x)], 1u);
        const unsigned gen = old / nloc;
        if (old + 1u == (gen + 1u) * nloc) {
            __builtin_amdgcn_fence(__ATOMIC_RELEASE, "agent");
            asm volatile("s_waitcnt vmcnt(0)" ::: "memory");
            const unsigned og = xb_add(&bar[XB_TOP], 1u);
            const unsigned tg = og / nx;
            if (og + 1u == (tg + 1u) * nx) xb_add(&bar[XB_TOPGEN], 1u);
            else XB_SPIN(xb_ld(&bar[XB_TOPGEN]) == tg, bar);
            __builtin_amdgcn_fence(__ATOMIC_ACQUIRE, "agent");
            xb_add(&bar[XB_XGEN(b.x)], 1u);
            asm volatile("s_waitcnt vmcnt(0)" ::: "memory");
        } else {
            XB_SPIN(xb_ld(&bar[XB_XGEN(b.x)]) == gen, bar);
            __builtin_amdgcn_fence(__ATOMIC_ACQUIRE, "agent");
            asm volatile("s_waitcnt vmcnt(0)" ::: "memory");
        }
    }
    __syncthreads();
}
constexpr int NWAVES = 8, NTHR = 512;
constexpr int D = 1024, T = 4096, CT = 256, NB = 4, NH = 8, DK = 128, FF = 4096, INT = 11296;
constexpr int ML = NB * T, MC = NB * CT, MR = ML + MC;
constexpr int NCH = 68;
constexpr float EPS = 1e-6f;
constexpr int NW1 = 11520, R_QKV = 0, R_AB = 3072, R_G2 = 3328, R_GA = 7424, R_GB = 8448, R_MG = 9472;
constexpr int N_G1 = 3328, N_G2 = 4096, N_G3 = 4096;
constexpr size_t MiB = 1u << 20;
constexpr size_t WS_CTL = 0, CTL_ZERO_BYTES = 1 * MiB;
constexpr size_t WS_MOD = 1 * MiB, WS_LB = WS_MOD + 128 * 1024;
constexpr size_t WS_LA = 1 * MiB + 512 * 1024, WS_BE = 2 * MiB + 768 * 1024;
constexpr size_t WS_ZQ = 4 * MiB;
constexpr size_t WS_QKVC = 106 * MiB;
constexpr size_t WS_TM = 208 * MiB;
constexpr size_t WS_WSM = 242 * MiB;
constexpr size_t WS_END = 256 * MiB;
constexpr size_t DO_H = 0;
constexpr size_t DO_WIN = 34 * MiB;
constexpr size_t DO_GB = 57 * MiB;
constexpr int CW_TMO = 0, CW_BAR = 4096, CW_ERR = 131072;
constexpr int LDS_BYTES = 147456, MISC_OFF = LDS_BYTES - 256;

struct Args { const float* in[19]; float* out; unsigned char* ws; int ph_lo, ph_hi, li, pad; };
static_assert(sizeof(Args) == 19 * 8 + 8 + 8 + 16, "Args has no padding");

struct Frame {
    LAS unsigned char* lds; volatile LAS unsigned* MISC; gu32* ctl;
    int tid, lane, wave, vcu, G;
    const float *x, *c, *ctx, *c_ctx, *w_ada, *b_ada, *norm_g, *w_in, *conv_w, *a_log, *dt_bias, *gdn_nw, *lb_logits, *hgrn_nw, *w_ba, *w_bb, *w_out, *w1, *w2;
    float* out; unsigned char* ws; unsigned char* dob;
};

__device__ __forceinline__ void p0_transpose_item(const float* W, int ldw, int k0, int c0, bf16* WT, int ldt, int r0, LAS float* scr, int lane) {
#pragma unroll 8
    for (int i = 0; i < 32; ++i) { const int kk = 2 * i + (lane >> 5); scr[kk * 33 + (lane & 31)] = W[(size_t)(k0 + kk) * ldw + c0 + (lane & 31)]; }
    LDS_WAIT(); asm volatile("" ::: "memory");
    const int c = lane & 7;
#pragma unroll
    for (int j = 0; j < 4; ++j) { const int n = (lane >> 3) + 8 * j; const LAS float* s = scr + (8 * c) * 33 + n;
        v4u o; o.x = pk2(s[0 * 33], s[1 * 33]); o.y = pk2(s[2 * 33], s[3 * 33]); o.z = pk2(s[4 * 33], s[5 * 33]); o.w = pk2(s[6 * 33], s[7 * 33]);
        *(GAS v4u*)(WT + (size_t)(r0 + n) * ldt + k0 + 8 * c) = o; }
    LDS_WAIT(); asm volatile("" ::: "memory");
}
__device__ __forceinline__ void p0_prologue(Frame& F) {
    LAS float* scr = (LAS float*)(F.lds + F.wave * 8704);
    const int gw = F.vcu * NWAVES + F.wave, NGW = F.G * NWAVES;
    bf16* WinT = (bf16*)(F.dob + DO_WIN); bf16* WaT = (bf16*)(F.ws + WS_WSM); bf16* WbT = WaT + (size_t)D * D; bf16* WoT = WbT + (size_t)D * D; bf16* W1T = WoT + (size_t)D * D;
    if (F.vcu < 192) {
        LAS float* sil = (LAS float*)(F.lds + 8 * 8704);
        LAS float* part = (LAS float*)(F.lds + 8 * 8704 + 20480);
        for (int i = F.tid; i < 5 * D; i += NTHR) { const int r = i >> 10, k = i & 1023; sil[i] = siluf(r < 4 ? F.c[r * D + k] : F.c_ctx[k]); }
        __syncthreads();
        for (int cb = F.vcu; cb < 192; cb += F.G) {
            const int n = cb * 32 + (F.lane & 31), kh = F.lane >> 5;
            float a0 = 0.f, a1 = 0.f, a2 = 0.f, a3 = 0.f, a4 = 0.f;
#pragma unroll 16
            for (int i = 0; i < 64; ++i) { const int k = F.wave * 128 + 2 * i + kh; const float w = F.w_ada[(size_t)k * 6 * D + n];
                a0 += sil[k] * w; a1 += sil[D + k] * w; a2 += sil[2 * D + k] * w; a3 += sil[3 * D + k] * w; a4 += sil[4 * D + k] * w; }
            a0 += __shfl_xor(a0, 32); a1 += __shfl_xor(a1, 32); a2 += __shfl_xor(a2, 32); a3 += __shfl_xor(a3, 32); a4 += __shfl_xor(a4, 32);
            if (F.lane < 32) { part[(F.wave * 5 + 0) * 32 + F.lane] = a0; part[(F.wave * 5 + 1) * 32 + F.lane] = a1; part[(F.wave * 5 + 2) * 32 + F.lane] = a2; part[(F.wave * 5 + 3) * 32 + F.lane] = a3; part[(F.wave * 5 + 4) * 32 + F.lane] = a4; }
            __syncthreads();
            if (F.tid < 160) { const int r = F.tid >> 5, cc = F.tid & 31; float s = 0.f;
#pragma unroll
                for (int w = 0; w < 8; ++w) s += part[(w * 5 + r) * 32 + cc];
                const int col = cb * 32 + cc; ((float*)(F.ws + WS_MOD))[r * 6 * D + col] = s + F.b_ada[col]; }
            __syncthreads();
        }
    }
    if (F.vcu == F.G - 1) {
        float* lb = (float*)(F.ws + WS_LB);
        for (int i = F.tid; i < 2 * D; i += NTHR) { const float l0 = F.lb_logits[i], l1 = F.lb_logits[2 * D + i], m = fmaxf(l0, l1), e0 = __expf(l0 - m), e1 = __expf(l1 - m); lb[i] = e0 / (e0 + e1); }
    }
    { v4u z = {0u, 0u, 0u, 0u}; GAS v4u* p = (GAS v4u*)(WinT + (size_t)(R_AB + 32) * D); const int n16 = 224 * D * 2 / 16;
      for (int i = F.vcu * NTHR + F.tid; i < n16; i += F.G * NTHR) p[i] = z; }
    constexpr int NITEMS = 16 * (96 + 1 + 128 + 32 + 32 + 64 + 32 + 32 + 32 + 128);
    for (int it = gw; it < NITEMS; it += NGW) {
        int r = it;
#define TRSEG(W_, ldw_, K_, c0_, ncols_, WT_, ldt_, r0_) { const int nblk_ = (ncols_) / 32, n_ = ((K_) / 64) * nblk_; \
            if (r < n_) { const int kb_ = r / nblk_, nb_ = r % nblk_; p0_transpose_item(W_, ldw_, 64 * kb_, (c0_) + 32 * nb_, WT_, ldt_, (r0_) + 32 * nb_, scr, F.lane); continue; } r -= n_; }
        TRSEG(F.w_in, INT, D, 0, 3072, WinT, D, R_QKV)
        TRSEG(F.w_in, INT, D, 4096, 32, WinT, D, R_AB)
        TRSEG(F.w_in, INT, D, 4128, 4096, WinT, D, R_G2)
        TRSEG(F.w_in, INT, D, 3072, 1024, WinT, D, R_GA)
        TRSEG(F.w_in, INT, D, 8224, 1024, WinT, D, R_GB)
        TRSEG(F.w_in, INT, D, 9248, 2048, WinT, D, R_MG)
        TRSEG(F.w_ba, D, D, 0, D, WaT, D, 0)
        TRSEG(F.w_bb, D, D, 0, D, WbT, D, 0)
        TRSEG(F.w_out, D, D, 0, D, WoT, D, 0)
        TRSEG(F.w1, FF, D, 0, FF, W1T, D, 0)
#undef TRSEG
    }
}
__device__ __forceinline__ void p1_hrows(Frame& F) {
    const int gw = F.vcu * NWAVES + F.wave, NGW = F.G * NWAVES;
    bf16* H = (bf16*)(F.dob + DO_H); const float* mod = (const float*)(F.ws + WS_MOD);
    for (int m = gw; m < MR; m += NGW) {
        const float* xr = m < ML ? F.x + (size_t)m * D : F.ctx + (size_t)(m - ML) * D;
        const float* mr = mod + (size_t)(m < ML ? (m >> 12) : 4) * 6 * D;
        const GAS f32x4* xp = (const GAS f32x4*)xr + F.lane;
        f32x4 v[4]; float s = 0.f;
#pragma unroll
        for (int j = 0; j < 4; ++j) { v[j] = xp[64 * j]; s += (v[j].x * v[j].x + v[j].y * v[j].y) + (v[j].z * v[j].z + v[j].w * v[j].w); }
        const float inv = 1.0f / sqrtf(wave_sum(s) * (1.f / D) + EPS);
        GAS v2u* o8 = (GAS v2u*)(H + (size_t)m * D) + F.lane;
#pragma unroll
        for (int j = 0; j < 4; ++j) { const int col = 4 * F.lane + 256 * j;
            const f32x4 g = *(const f32x4*)(F.norm_g + col), sh = *(const f32x4*)(mr + col), sc = *(const f32x4*)(mr + D + col);
            const f32x4 h = (v[j] * inv * g) * (sc + 1.0f) + sh;
            v2u o; o.x = pk2(h.x, h.y); o.y = pk2(h.z, h.w); o8[64 * j] = o; }
    }
}
struct EpiG1 {
    static constexpr bool PERM = true, AFTER_DRAIN = false;
    bf16* Zq; float* la; float* be; const float* a_log; const float* dt_bias;
    __device__ __forceinline__ void operator()(const pg8::f32x4 (&acc)[2][2][4][2], const pg8::Unit& u, int wr, int wc, int fr, int fq) const {
        const int row0 = u.pm * 256 + wr * 64 + fr;
        if (u.pn < 12) {
            const int col0 = u.pn * 256 + wc * 32 + 8 * fq;
#pragma unroll
            for (int ai = 0; ai < 2; ++ai)
#pragma unroll
                for (int m = 0; m < 4; ++m) { bf16* rowp = Zq + (size_t)(row0 + ai * 128 + m * 16) * 3072 + col0;
#pragma unroll
                    for (int bj = 0; bj < 2; ++bj) { const pg8::f32x4 v0 = acc[ai][bj][m][0], v1 = acc[ai][bj][m][1];
                        pg8::u32x4 w; w.x = pg8::cvt_pk_bf16(v0[0], v0[1]); w.y = pg8::cvt_pk_bf16(v0[2], v0[3]); w.z = pg8::cvt_pk_bf16(v1[0], v1[1]); w.w = pg8::cvt_pk_bf16(v1[2], v1[3]);
                        *(pg8::u32x4*)(rowp + bj * 128) = w; } }
        } else if (wc == 0) {
#pragma unroll
            for (int n = 0; n < 2; ++n) { const int c0 = 8 * fq + 4 * n;
                if (c0 < 16) { const f32x4 al = *(const f32x4*)(a_log + c0), dt = *(const f32x4*)(dt_bias + c0);
#pragma unroll
                    for (int ai = 0; ai < 2; ++ai)
#pragma unroll
                        for (int m = 0; m < 4; ++m) { const pg8::f32x4 v = acc[ai][0][m][n]; f32x4 o;
                            o.x = -__expf(al.x) * softplusf(v[0] + dt.x); o.y = -__expf(al.y) * softplusf(v[1] + dt.y); o.z = -__expf(al.z) * softplusf(v[2] + dt.z); o.w = -__expf(al.w) * softplusf(v[3] + dt.w);
                            *(f32x4*)(la + (size_t)(row0 + ai * 128 + m * 16) * 16 + c0) = o; }
                } else {
#pragma unroll
                    for (int ai = 0; ai < 2; ++ai)
#pragma unroll
                        for (int m = 0; m < 4; ++m) { const pg8::f32x4 v = acc[ai][0][m][n]; f32x4 o; o.x = sigm(v[0]); o.y = sigm(v[1]); o.z = sigm(v[2]); o.w = sigm(v[3]);
                            *(f32x4*)(be + (size_t)(row0 + ai * 128 + m * 16) * 16 + (c0 - 16)) = o; }
                } }
        }
    }
};
namespace prep {
constexpr int ST = 0, KS = 50688, AC = 67072, GBL = 132608;
constexpr int NUNITS = NB * NCH * 2;
}
__device__ __forceinline__ int chunk_tok0(int b, int n) { return n < 4 ? ML + b * CT + 64 * n : b * T + 64 * (n - 4); }

__device__ __forceinline__ void tri_solve_lower(const LAS float* Ab, int c, float (&X)[64]) {
    int z0 = 0, z1 = 0;
#pragma unroll
    for (int i = 0; i < 64; ++i) {
        const LAS float* row = Ab + i * 64 + z0;
        float s0 = (i == c) ? 1.f : 0.f, s1 = 0.f, s2 = 0.f, s3 = 0.f;
#pragma unroll
        for (int jj = 0; jj < (i + 3) / 4; ++jj) {
            const f32x4 a = *(const LAS f32x4*)(row + 4 * jj);
            if (4 * jj + 0 < i) s0 -= a.x * X[4 * jj + 0];
            if (4 * jj + 1 < i) s1 -= a.y * X[4 * jj + 1];
            if (4 * jj + 2 < i) s2 -= a.z * X[4 * jj + 2];
            if (4 * jj + 3 < i) s3 -= a.w * X[4 * jj + 3];
        }
        X[i] = (s0 + s1) + (s2 + s3);
        z0 = z1; int t = 0; asm volatile("" : "+v"(t), "+v"(X[i])); z1 = t;
    }
}
__device__ __forceinline__ void tri_solve_upper(const LAS float* Ab, int c, float (&X)[64]) {
    int z0 = 0, z1 = 0;
#pragma unroll
    for (int i = 63; i >= 0; --i) {
        const LAS float* row = Ab + i * 64 + z0;
        float s0 = (i == c) ? 1.f : 0.f, s1 = 0.f, s2 = 0.f, s3 = 0.f;
#pragma unroll
        for (int jj = (i + 1) / 4; jj < 16; ++jj) {
            const f32x4 a = *(const LAS f32x4*)(row + 4 * jj);
            if (4 * jj + 0 > i) s0 -= a.x * X[4 * jj + 0];
            if (4 * jj + 1 > i) s1 -= a.y * X[4 * jj + 1];
            if (4 * jj + 2 > i) s2 -= a.z * X[4 * jj + 2];
            if (4 * jj + 3 > i) s3 -= a.w * X[4 * jj + 3];
        }
        X[i] = (s0 + s1) + (s2 + s3);
        z0 = z1; int t = 0; asm volatile("" : "+v"(t), "+v"(X[i])); z1 = t;
    }
}

__device__ __forceinline__ void p3_gdn_prep(Frame& F) {
    using namespace prep;
    const bf16* Zq = (const bf16*)(F.ws + WS_ZQ); bf16* QKVc = (bf16*)(F.ws + WS_QKVC); bf16* TM = (bf16*)(F.ws + WS_TM); float* GB = (float*)(F.dob + DO_GB);
    const float* la = (const float*)(F.ws + WS_LA); const float* be = (const float*)(F.ws + WS_BE);
    LAS unsigned char* st = F.lds + ST; LAS unsigned char* ks = F.lds + KS; LAS float* ac = (LAS float*)(F.lds + AC); LAS float* gbl = (LAS float*)(F.lds + GBL);
    const int wave = F.wave;
    for (int unit = F.vcu; unit < NUNITS; unit += F.G) {
        int tid = F.tid; asm volatile("" : "+v"(tid));
        const int lane = tid & 63;
        const int hg = unit & 1, n = (unit >> 1) % NCH, b = (unit >> 1) / NCH;
        const bool isctx = n < 4; const int r = n - 4;
        const int tok0 = chunk_tok0(b, n);
        __syncthreads();
        { const int hl = wave >> 1, dir = wave & 1, h = hg * 4 + hl;
          float g = la[(size_t)(tok0 + lane) * 16 + dir * 8 + h]; const float bt = be[(size_t)(tok0 + lane) * 16 + dir * 8 + h];
          if (dir == 0) {
#pragma unroll
              for (int o = 1; o < 64; o <<= 1) { const float t = __shfl_up(g, o); if (lane >= o) g += t; }
          } else {
#pragma unroll
              for (int o = 1; o < 64; o <<= 1) { const float t = __shfl_down(g, o); if (lane + o < 64) g += t; }
          }
          gbl[((hl * 2 + dir) * 2 + 0) * 64 + lane] = g; gbl[((hl * 2 + dir) * 2 + 1) * 64 + lane] = bt;
          float* gb = GB + ((size_t)((b * NCH + n) * NH + h) * 2 + dir) * 128; const int id = dir == 0 ? lane : 63 - lane;
          gb[id] = g; gb[64 + id] = bt; }
        v4u pre[6]; v4u prehalo;
#define P3_ISSUE(part_) do { const int hl_ = (part_) / 3, p_ = (part_) % 3, cb_ = p_ * 1024 + (hg * 4 + hl_) * 128; \
            _Pragma("unroll") for (int k = 0; k < 6; ++k) { const int q = tid + 512 * k, dy = q >> 10, c = (q >> 4) & 63, k16 = q & 15; \
                bool ok; int tok; \
                if (isctx) { ok = dy == 1; tok = tok0 + c; } else { const int rr = r + dy - 1; ok = rr >= 0 && rr < 64; tok = b * T + rr * 64 + c; } \
                pre[k] = ok ? *(const GAS v4u*)(Zq + (size_t)tok * 3072 + cb_ + k16 * 8) : (v4u){0u, 0u, 0u, 0u}; } \
            prehalo = (v4u){0u, 0u, 0u, 0u}; \
            if (isctx && (tid >> 5) == 1) { const int side = (tid >> 4) & 1, k16 = tid & 15, t = side == 0 ? 64 * n - 1 : 64 * n + 64; \
                if (t >= 0 && t < CT) prehalo = *(const GAS v4u*)(Zq + (size_t)(ML + b * CT + t) * 3072 + cb_ + k16 * 8); } } while (0)
        P3_ISSUE(0);
        for (int part = 0; part < 12; ++part) {
            const int hl = part / 3, p = part % 3, h = hg * 4 + hl, cb = p * 1024 + h * 128;
            __syncthreads();
#pragma unroll
            for (int k = 0; k < 6; ++k) { const int q = tid + 512 * k, dy = q >> 10, c = (q >> 4) & 63, k16 = q & 15;
                *(LAS v4u*)(st + ((dy * 66 + c + 1) * 256 + k16 * 16)) = pre[k]; }
            if (tid < 96) { const int dy = tid >> 5, side = (tid >> 4) & 1, k16 = tid & 15;
                *(LAS v4u*)(st + ((dy * 66 + side * 65) * 256 + k16 * 16)) = (dy == 1) ? prehalo : (v4u){0u, 0u, 0u, 0u}; }
            __syncthreads();
            if (part + 1 < 12) P3_ISSUE(part + 1);
            { const int ch4 = tid & 31, tg = tid >> 5, c0 = 4 * tg;
              float y[4][4];
#pragma unroll
              for (int j = 0; j < 4; ++j)
#pragma unroll
                  for (int e = 0; e < 4; ++e) y[j][e] = 0.f;
#pragma unroll
              for (int dy = 0; dy < 3; ++dy) {
                  float in[6][4];
#pragma unroll
                  for (int x = 0; x < 6; ++x) { const v2u w = *(const LAS v2u*)(st + ((dy * 66 + c0 + x) * 256 + ch4 * 8)); in[x][0] = bflo(w.x); in[x][1] = bfhi(w.x); in[x][2] = bflo(w.y); in[x][3] = bfhi(w.y); }
#pragma unroll
                  for (int dx = 0; dx < 3; ++dx) { const f32x4 w = *(const f32x4*)(F.conv_w + (size_t)(dy * 3 + dx) * 3072 + cb + 4 * ch4);
#pragma unroll
                      for (int j = 0; j < 4; ++j) { y[j][0] += w.x * in[j + dx][0]; y[j][1] += w.y * in[j + dx][1]; y[j][2] += w.z * in[j + dx][2]; y[j][3] += w.w * in[j + dx][3]; } }
              }
#pragma unroll
              for (int j = 0; j < 4; ++j) {
#pragma unroll
                  for (int e = 0; e < 4; ++e) y[j][e] = siluf(y[j][e]);
                  float sc = 1.f;
                  if (p < 2) { float s = (y[j][0] * y[j][0] + y[j][1] * y[j][1]) + (y[j][2] * y[j][2] + y[j][3] * y[j][3]);
#pragma unroll
                      for (int o = 1; o < 32; o <<= 1) s += __shfl_xor(s, o);
                      sc = __builtin_amdgcn_rsqf(s + EPS) * (p == 0 ? 0.08838834764831845f : 1.0f); }
                  v2u o; o.x = pk2(y[j][0] * sc, y[j][1] * sc); o.y = pk2(y[j][2] * sc, y[j][3] * sc);
                  const int row = c0 + j;
                  *(GAS v2u*)(QKVc + (size_t)(tok0 + row) * 3072 + cb + 4 * ch4) = o;
                  if (p == 1) *(LAS v2u*)(ks + row * 256 + ((((ch4 >> 1) ^ (row & 7)) << 4) | ((ch4 & 1) << 3))) = o;
              } }
            if (p == 1) {
                __syncthreads();
                const int fr = lane & 15, fq = lane >> 4;
                LAS float* A = ac + hl * 4096;
                const LAS float* g0 = gbl + ((hl * 2 + 0) * 2 + 0) * 64; const LAS float* b0 = g0 + 64; const LAS float* g1 = gbl + ((hl * 2 + 1) * 2 + 0) * 64; const LAS float* b1 = g1 + 64;
#pragma unroll
                for (int tt = 0; tt < 2; ++tt) { const int t = 2 * wave + tt, ti = t >> 2, tj = t & 3;
                    pg8::f32x4 acc = {0.f, 0.f, 0.f, 0.f};
#pragma unroll
                    for (int kk = 0; kk < 4; ++kk) { const int ra = 16 * ti + fr, rb = 16 * tj + fr, ch = kk * 4 + fq;
                        const bf16x8 fa = *(const LAS bf16x8*)(ks + ra * 256 + ((ch ^ (ra & 7)) << 4)); const bf16x8 fb = *(const LAS bf16x8*)(ks + rb * 256 + ((ch ^ (rb & 7)) << 4));
                        acc = __builtin_amdgcn_mfma_f32_16x16x32_bf16(fa, fb, acc, 0, 0, 0); }
                    const int j = 16 * tj + fr;
#pragma unroll
                    for (int e = 0; e < 4; ++e) { const int i = 16 * ti + 4 * fq + e; float v = 0.f;
                        if (j < i) v = b0[i] * acc[e] * __expf(g0[i] - g0[j]);
                        else if (j > i) v = b1[i] * acc[e] * __expf(g1[i] - g1[j]);
                        A[i * 64 + j] = v; } }
            }
        }
        __syncthreads();
        { const int hl = wave >> 1, dir = wave & 1, h = hg * 4 + hl;
          const LAS float* A = ac + hl * 4096; float X[64]; int cl = lane; asm volatile("" : "+v"(cl));
          bf16* tm = TM + ((size_t)((b * NCH + n) * NH + h) * 2 + dir) * 4096;
          if (dir == 0) { tri_solve_lower(A, cl, X);
#pragma unroll
              for (int i = 0; i < 64; ++i) tm[i * 64 + lane] = (bf16)f2bf(X[i]);
          } else { tri_solve_upper(A, cl, X);
#pragma unroll
              for (int i = 0; i < 64; ++i) tm[(63 - i) * 64 + (63 - lane)] = (bf16)f2bf(X[i]);
          } }
    }
#undef P3_ISSUE
}
__device__ __forceinline__ unsigned off_b(unsigned row, unsigned ch) { return 256u * row + 16u * (ch ^ (((row & 3) << 2) | ((row >> 2) & 3))); }
__device__ __forceinline__ unsigned off64(unsigned row, unsigned ch) { return 128u * row + 16u * (ch ^ ((row >> 1) & 7)); }
__device__ __forceinline__ unsigned off_v(unsigned row, unsigned ch) { return 64u * row + 16u * (ch ^ ((row >> 1) & 3)); }
__device__ __forceinline__ unsigned tr_addr_b(unsigned lane, unsigned c, unsigned ks, unsigned t) { const unsigned g = lane >> 4, q = (lane & 15) >> 2, p = lane & 3; return off_b(32 * ks + 8 * g + 4 * t + q, 2 * c + (p >> 1)) + 8 * (p & 1); }
__device__ __forceinline__ unsigned tr_addr_v(unsigned lane, unsigned c, unsigned ks, unsigned t) { const unsigned g = lane >> 4, q = (lane & 15) >> 2, p = lane & 3; return off_v(32 * ks + 8 * g + 4 * t + q, 2 * c + (p >> 1)) + 8 * (p & 1); }
__device__ __forceinline__ bf16x8 tr_frag(unsigned a0, unsigned a1) {
    v2u r0, r1;
    asm volatile("ds_read_b64_tr_b16 %0, %2\n\tds_read_b64_tr_b16 %1, %3\n\ts_waitcnt lgkmcnt(0)" : "=&v"(r0), "=&v"(r1) : "v"(a0), "v"(a1) : "memory");
    v4u w; w.x = r0.x; w.y = r0.y; w.z = r1.x; w.w = r1.y; return __builtin_bit_cast(bf16x8, w);
}
namespace gscan {
constexpr int QS = 0, KSI = 16384, TP = 32768, TPP = 40960, VS = 49152, ATT = 53248, NW = 61440, STI = 77824, VN1 = 86016, VN2 = 90112, GF = 94208;
constexpr int NV = 32, NITEMS = NB * NH * 2 * 4;
}
constexpr size_t WS_OAF = 4 * MiB, WS_OAB = 36 * MiB;

__device__ __forceinline__ void p4_gdn_scan(Frame& F) {
    using namespace gscan;
    const bf16* QKVc = (const bf16*)(F.ws + WS_QKVC); const bf16* TM = (const bf16*)(F.ws + WS_TM); const float* GB = (const float*)(F.dob + DO_GB);
    LAS unsigned char* L = F.lds; const unsigned LB = (unsigned)(unsigned long long)F.lds;
    LAS float* eg = (LAS float*)(L + GF); LAS float* dg = eg + 64; LAS float* gs = eg + 128;
    const int wave = F.wave;
    for (int item = F.vcu; item < NITEMS; item += F.G) {
        int tid = F.tid; asm volatile("" : "+v"(tid));
        const int lane = tid & 63, fr = lane & 15, fq = lane >> 4;
        const int vs = item & 3, dir = (item >> 2) & 1, h = (item >> 3) & 7, b = item >> 6;
        bf16* Oout = (bf16*)(F.ws + (dir == 0 ? WS_OAF : WS_OAB));
        pg8::f32x4 Sacc[2] = {{0.f, 0.f, 0.f, 0.f}, {0.f, 0.f, 0.f, 0.f}};
        __syncthreads();
        for (int i = tid; i < 8192 / 4; i += NTHR) ((LAS unsigned*)(L + STI))[i] = 0u;
        v4u pq[2], pk[2], pv, pt; f32x4 pg0, pg1, pb0, pb1; float pgl, pgi;
#define P4_ISSUE(s_) do { const int nm_ = dir == 0 ? (s_) : ((s_) < 4 ? 3 - (s_) : 67 - ((s_) - 4)); const int tk0_ = chunk_tok0(b, nm_); \
        _Pragma("unroll") for (int k = 0; k < 2; ++k) { const int q = tid + 512 * k, i = q >> 4, ch = q & 15; const size_t ro = (size_t)(tk0_ + (dir == 0 ? i : 63 - i)) * 3072 + h * 128 + ch * 8; \
            pq[k] = *(const GAS v4u*)(QKVc + ro); pk[k] = *(const GAS v4u*)(QKVc + ro + 1024); } \
        if (tid < 256) { const int j = tid >> 2, ch = tid & 3; pv = *(const GAS v4u*)(QKVc + (size_t)(tk0_ + (dir == 0 ? j : 63 - j)) * 3072 + 2048 + h * 128 + NV * vs + ch * 8); } \
        const size_t ci_ = ((size_t)((b * NCH + nm_) * NH + h) * 2 + dir); \
        pt = *(const GAS v4u*)(TM + ci_ * 4096 + (tid >> 3) * 64 + (tid & 7) * 8); \
        const float* gb_ = GB + ci_ * 128; pg0 = *(const f32x4*)(gb_ + (tid & 7) * 8); pg1 = *(const f32x4*)(gb_ + (tid & 7) * 8 + 4); pb0 = *(const f32x4*)(gb_ + 64 + (tid & 7) * 8); pb1 = *(const f32x4*)(gb_ + 64 + (tid & 7) * 8 + 4); \
        pgl = gb_[63]; pgi = gb_[lane]; } while (0)
        P4_ISSUE(0);
        for (int s = 0; s < NCH; ++s) {
            const int nm = dir == 0 ? s : (s < 4 ? 3 - s : 67 - (s - 4)); const int tok0 = chunk_tok0(b, nm);
#pragma unroll
            for (int k = 0; k < 2; ++k) { const int q = tid + 512 * k, i = q >> 4, ch = q & 15; *(LAS v4u*)(L + QS + off_b(i, ch)) = pq[k]; *(LAS v4u*)(L + KSI + off_b(i, ch)) = pk[k]; }
            if (tid < 256) { const int j = tid >> 2, ch = tid & 3; *(LAS v4u*)(L + VS + off_v(j, ch)) = pv; }
            { const int i = tid >> 3, ch = tid & 7; const float glast = pgl;
              const float sg[8] = {pg0.x, pg0.y, pg0.z, pg0.w, pg1.x, pg1.y, pg1.z, pg1.w}, sb[8] = {pb0.x, pb0.y, pb0.z, pb0.w, pb1.x, pb1.y, pb1.z, pb1.w};
              const unsigned tw[4] = {pt.x, pt.y, pt.z, pt.w}; unsigned o1[4], o2[4];
#pragma unroll
              for (int e = 0; e < 4; ++e) { const float t0 = bflo(tw[e]), t1 = bfhi(tw[e]);
                  o1[e] = pk2(t0 * sb[2 * e] * __expf(sg[2 * e]), t1 * sb[2 * e + 1] * __expf(sg[2 * e + 1])); o2[e] = pk2(t0 * sb[2 * e], t1 * sb[2 * e + 1]); }
              *(LAS v4u*)(L + TP + off64(i, ch)) = (v4u){o1[0], o1[1], o1[2], o1[3]}; *(LAS v4u*)(L + TPP + off64(i, ch)) = (v4u){o2[0], o2[1], o2[2], o2[3]};
              if (tid < 64) { eg[tid] = __expf(pgi); dg[tid] = __expf(glast - pgi); gs[tid] = pgi; } }
            const float dlast = __expf(pgl);
            __syncthreads();
            if (s + 1 < NCH) P4_ISSUE(s + 1);
#pragma unroll
            for (int tt = 0; tt < 2; ++tt) { const int t = 2 * wave + tt, tj = t >> 2, ti = t & 3;
                pg8::f32x4 acc = {0.f, 0.f, 0.f, 0.f};
                if (tj <= ti) {
#pragma unroll
                    for (int ks = 0; ks < 4; ++ks) { const bf16x8 fa = *(const LAS bf16x8*)(L + KSI + off_b(16 * tj + fr, 4 * ks + fq)), fb = *(const LAS bf16x8*)(L + QS + off_b(16 * ti + fr, 4 * ks + fq));
                        acc = __builtin_amdgcn_mfma_f32_16x16x32_bf16(fa, fb, acc, 0, 0, 0); } }
                const int i = 16 * ti + fr, j0 = 16 * tj + 4 * fq; const float gi = gs[i]; float o[4];
#pragma unroll
                for (int e = 0; e < 4; ++e) { const int j = j0 + e; o[e] = (j <= i) ? acc[e] * __expf(gi - gs[j]) : 0.f; }
                *(LAS v2u*)(L + ATT + off64(i, j0 >> 3) + (j0 & 4) * 2) = (v2u){pk2(o[0], o[1]), pk2(o[2], o[3])}; }
            bf16x8 kf[2];
#pragma unroll
            for (int ks = 0; ks < 2; ++ks) kf[ks] = tr_frag(LB + KSI + tr_addr_b(lane, wave, ks, 0), LB + KSI + tr_addr_b(lane, wave, ks, 1));
#pragma unroll
            for (int ti = 0; ti < 4; ++ti) { pg8::f32x4 acc = {0.f, 0.f, 0.f, 0.f};
#pragma unroll
                for (int ks = 0; ks < 2; ++ks) { const bf16x8 fb = *(const LAS bf16x8*)(L + TP + off64(16 * ti + fr, 4 * ks + fq)); acc = __builtin_amdgcn_mfma_f32_16x16x32_bf16(kf[ks], fb, acc, 0, 0, 0); }
                const int i = 16 * ti + fr, c0 = 16 * wave + 4 * fq;
                *(LAS v2u*)(L + NW + off_b(i, c0 >> 3) + (c0 & 4) * 2) = (v2u){pk2(-acc[0], -acc[1]), pk2(-acc[2], -acc[3])}; }
            pg8::f32x4 oacc = {0.f, 0.f, 0.f, 0.f}; const int otv = wave >> 2, oti = wave & 3;
#pragma unroll
            for (int ks = 0; ks < 4; ++ks) { const bf16x8 fa = *(const LAS bf16x8*)(L + STI + off_b(16 * otv + fr, 4 * ks + fq)), fb = *(const LAS bf16x8*)(L + QS + off_b(16 * oti + fr, 4 * ks + fq));
                oacc = __builtin_amdgcn_mfma_f32_16x16x32_bf16(fa, fb, oacc, 0, 0, 0); }
            { const float e = eg[16 * oti + fr]; oacc = oacc * e; }
            __syncthreads();
            { const int ti = wave >> 1, tv = wave & 1; pg8::f32x4 acc = {0.f, 0.f, 0.f, 0.f};
#pragma unroll
              for (int ks = 0; ks < 2; ++ks) { const bf16x8 fa = *(const LAS bf16x8*)(L + TPP + off64(16 * ti + fr, 4 * ks + fq)); const bf16x8 fb = tr_frag(LB + VS + tr_addr_v(lane, tv, ks, 0), LB + VS + tr_addr_v(lane, tv, ks, 1));
                  acc = __builtin_amdgcn_mfma_f32_16x16x32_bf16(fa, fb, acc, 0, 0, 0); }
#pragma unroll
              for (int ks = 0; ks < 4; ++ks) { const bf16x8 fa = *(const LAS bf16x8*)(L + NW + off_b(16 * ti + fr, 4 * ks + fq)), fb = *(const LAS bf16x8*)(L + STI + off_b(16 * tv + fr, 4 * ks + fq));
                  acc = __builtin_amdgcn_mfma_f32_16x16x32_bf16(fa, fb, acc, 0, 0, 0); }
              const int v = 16 * tv + fr, i0 = 16 * ti + 4 * fq; const f32x4 d4 = *(const LAS f32x4*)(dg + i0);
              *(LAS v2u*)(L + VN1 + off64(v, i0 >> 3) + (i0 & 4) * 2) = (v2u){pk2(acc[0], acc[1]), pk2(acc[2], acc[3])};
              *(LAS v2u*)(L + VN2 + off64(v, i0 >> 3) + (i0 & 4) * 2) = (v2u){pk2(acc[0] * d4.x, acc[1] * d4.y), pk2(acc[2] * d4.z, acc[3] * d4.w)}; }
            __syncthreads();
#pragma unroll
            for (int ks = 0; ks < 2; ++ks) { const bf16x8 fa = *(const LAS bf16x8*)(L + VN1 + off64(16 * otv + fr, 4 * ks + fq)), fb = *(const LAS bf16x8*)(L + ATT + off64(16 * oti + fr, 4 * ks + fq));
                oacc = __builtin_amdgcn_mfma_f32_16x16x32_bf16(fa, fb, oacc, 0, 0, 0); }
            if (nm >= 4) { const int i = 16 * oti + fr, v0 = 16 * otv + 4 * fq; const int tok = tok0 + (dir == 0 ? i : 63 - i);
                *(GAS v2u*)(Oout + (size_t)tok * 1024 + h * 128 + NV * vs + v0) = (v2u){pk2(oacc[0], oacc[1]), pk2(oacc[2], oacc[3])}; }
#pragma unroll
            for (int tv = 0; tv < 2; ++tv) { pg8::f32x4 acc = Sacc[tv] * dlast;
#pragma unroll
                for (int ks = 0; ks < 2; ++ks) { const bf16x8 fb = *(const LAS bf16x8*)(L + VN2 + off64(16 * tv + fr, 4 * ks + fq)); acc = __builtin_amdgcn_mfma_f32_16x16x32_bf16(kf[ks], fb, acc, 0, 0, 0); }
                Sacc[tv] = acc; }
            __syncthreads();
#pragma unroll
            for (int tv = 0; tv < 2; ++tv) { const int v = 16 * tv + fr, c0 = 16 * wave + 4 * fq;
                *(LAS v2u*)(L + STI + off_b(v, c0 >> 3) + (c0 & 4) * 2) = (v2u){pk2(Sacc[tv][0], Sacc[tv][1]), pk2(Sacc[tv][2], Sacc[tv][3])}; }
        }
#undef P4_ISSUE
    }
}
struct EpiStore {
    static constexpr bool PERM = true, AFTER_DRAIN = false;
    bf16* O; int ldc;
    __device__ __forceinline__ void operator()(const pg8::f32x4 (&acc)[2][2][4][2], const pg8::Unit& u, int wr, int wc, int fr, int fq) const {
        const int row0 = u.pm * 256 + wr * 64 + fr, col0 = u.pn * 256 + wc * 32 + 8 * fq;
#pragma unroll
        for (int ai = 0; ai < 2; ++ai)
#pragma unroll
            for (int m = 0; m < 4; ++m) { bf16* rowp = O + (size_t)(row0 + ai * 128 + m * 16) * ldc + col0;
#pragma unroll
                for (int bj = 0; bj < 2; ++bj) { const pg8::f32x4 v0 = acc[ai][bj][m][0], v1 = acc[ai][bj][m][1];
                    pg8::u32x4 w; w.x = pg8::cvt_pk_bf16(v0[0], v0[1]); w.y = pg8::cvt_pk_bf16(v0[2], v0[3]); w.z = pg8::cvt_pk_bf16(v1[0], v1[1]); w.w = pg8::cvt_pk_bf16(v1[2], v1[3]);
                    *(pg8::u32x4*)(rowp + bj * 128) = w; } }
    }
};
constexpr size_t WS_NA = 68 * MiB, WS_NB = 100 * MiB;
constexpr size_t WS_ZH = 106 * MiB;
constexpr size_t WS_OBF = 4 * MiB, WS_OBB = 36 * MiB;
__device__ __forceinline__ void combine_norm(Frame& F, const bf16* Of, const bf16* Ob, const float* nw, bf16* N) {
    const int gw = F.vcu * NWAVES + F.wave, NGW = F.G * NWAVES; const int lane = F.lane;
    f32x4 w4[4];
#pragma unroll
    for (int j = 0; j < 4; ++j) w4[j] = *(const f32x4*)(nw + (16 * lane) % 128 + 4 * j);
    for (int t = gw; t < ML; t += NGW) {
        const size_t o = (size_t)t * 1024 + 16 * lane;
        const v4u a0 = *(const GAS v4u*)(Of + o), a1 = *(const GAS v4u*)(Of + o + 8), b0 = *(const GAS v4u*)(Ob + o), b1 = *(const GAS v4u*)(Ob + o + 8);
        const unsigned aw[8] = {a0.x, a0.y, a0.z, a0.w, a1.x, a1.y, a1.z, a1.w}, bw[8] = {b0.x, b0.y, b0.z, b0.w, b1.x, b1.y, b1.z, b1.w};
        float v[16]; float s = 0.f;
#pragma unroll
        for (int e = 0; e < 8; ++e) { v[2 * e] = bflo(aw[e]) + bflo(bw[e]); v[2 * e + 1] = bfhi(aw[e]) + bfhi(bw[e]); s += v[2 * e] * v[2 * e] + v[2 * e + 1] * v[2 * e + 1]; }
        s += __shfl_xor(s, 1); s += __shfl_xor(s, 2); s += __shfl_xor(s, 4);
        const float inv = 1.0f / sqrtf(s * (1.f / 128.f) + EPS);
        const float wv[16] = {w4[0].x, w4[0].y, w4[0].z, w4[0].w, w4[1].x, w4[1].y, w4[1].z, w4[1].w, w4[2].x, w4[2].y, w4[2].z, w4[2].w, w4[3].x, w4[3].y, w4[3].z, w4[3].w};
        unsigned ow[8];
#pragma unroll
        for (int e = 0; e < 8; ++e) ow[e] = pk2(v[2 * e] * inv * wv[2 * e], v[2 * e + 1] * inv * wv[2 * e + 1]);
        *(GAS v4u*)(N + o) = (v4u){ow[0], ow[1], ow[2], ow[3]}; *(GAS v4u*)(N + o + 8) = (v4u){ow[4], ow[5], ow[6], ow[7]};
    }
}
constexpr size_t WS_SG = 132 * MiB;
constexpr size_t WS_TMP = 4 * MiB;
constexpr size_t WS_MB = 196 * MiB;
constexpr size_t WS_W2T = 228 * MiB;
constexpr size_t WS_H2 = 68 * MiB;
constexpr size_t WS_HID = 100 * MiB;

struct EpiG3 {
    static constexpr bool PERM = true, AFTER_DRAIN = false;
    unsigned char* ws;
    __device__ __forceinline__ void operator()(const pg8::f32x4 (&acc)[2][2][4][2], const pg8::Unit& u, int wr, int wc, int fr, int fq) const {
        const int row0 = u.pm * 256 + wr * 64 + fr;
        const bool gate = u.pn >= 8;
        const size_t boff = gate ? WS_SG : (u.pn >= 4 ? WS_NB : WS_NA); bf16* base = (bf16*)(ws + boff); const int ldc = gate ? 2048 : 1024;
        const int col0 = (gate ? (u.pn - 8) : (u.pn & 3)) * 256 + wc * 32 + 8 * fq;
#pragma unroll
        for (int ai = 0; ai < 2; ++ai)
#pragma unroll
            for (int m = 0; m < 4; ++m) { bf16* rowp = base + (size_t)(row0 + ai * 128 + m * 16) * ldc + col0;
#pragma unroll
                for (int bj = 0; bj < 2; ++bj) { const pg8::f32x4 v0 = acc[ai][bj][m][0], v1 = acc[ai][bj][m][1];
                    float o[8] = {v0[0], v0[1], v0[2], v0[3], v1[0], v1[1], v1[2], v1[3]};
                    if (gate) {
#pragma unroll
                        for (int e = 0; e < 8; ++e) o[e] = sigm(o[e]);
                    } else { const v4u nv = *(const GAS v4u*)(rowp + bj * 128); const unsigned nw[4] = {nv.x, nv.y, nv.z, nv.w};
#pragma unroll
                        for (int e = 0; e < 4; ++e) { o[2 * e] = bflo(nw[e]) * siluf(o[2 * e]); o[2 * e + 1] = bfhi(nw[e]) * siluf(o[2 * e + 1]); } }
                    pg8::u32x4 w; w.x = pk2(o[0], o[1]); w.y = pk2(o[2], o[3]); w.z = pk2(o[4], o[5]); w.w = pk2(o[6], o[7]);
                    *(pg8::u32x4*)(rowp + bj * 128) = w; } }
    }
};
template <int PASS> struct EpiMerge {
    static constexpr bool PERM = false, AFTER_DRAIN = false;
    const bf16* SG; float* tmp; bf16* Mb;
    __device__ __forceinline__ void operator()(const pg8::f32x4 (&acc)[2][2][4][2], const pg8::Unit& u, int wr, int wc, int fr, int fq) const {
        const int row0 = u.pm * 256 + wr * 64 + fr, col0 = u.pn * 256 + wc * 32 + 4 * fq;
#pragma unroll
        for (int ai = 0; ai < 2; ++ai)
#pragma unroll
            for (int m = 0; m < 4; ++m) { const size_t r = (size_t)(row0 + ai * 128 + m * 16);
#pragma unroll
                for (int bj = 0; bj < 2; ++bj)
#pragma unroll
                    for (int n = 0; n < 2; ++n) { const int c = col0 + bj * 128 + n * 16; const pg8::f32x4 v = acc[ai][bj][m][n];
                        const v2u sg = *(const GAS v2u*)(SG + r * 2048 + (PASS ? 1024 : 0) + c);
                        f32x4 o; o.x = bflo(sg.x) * v[0]; o.y = bfhi(sg.x) * v[1]; o.z = bflo(sg.y) * v[2]; o.w = bfhi(sg.y) * v[3];
                        if (PASS == 0) *(f32x4*)(tmp + r * 1024 + c) = o;
                        else { const f32x4 t = *(const f32x4*)(tmp + r * 1024 + c); o = o + t; *(GAS v2u*)(Mb + r * 1024 + c) = (v2u){pk2(o.x, o.y), pk2(o.z, o.w)}; } } }
    }
};
struct EpiF32S {
    static constexpr bool PERM = false, AFTER_DRAIN = false;
    float* C; int ldc;
    __device__ __forceinline__ void operator()(const pg8::f32x4 (&acc)[2][2][4][2], const pg8::Unit& u, int wr, int wc, int fr, int fq) const {
        const int row0 = u.pm * 256 + wr * 64 + fr, col0 = u.pn * 256 + wc * 32 + 4 * fq;
#pragma unroll
        for (int ai = 0; ai < 2; ++ai)
#pragma unroll
            for (int m = 0; m < 4; ++m) { float* rowp = C + (size_t)(row0 + ai * 128 + m * 16) * ldc + col0;
#pragma unroll
                for (int bj = 0; bj < 2; ++bj)
#pragma unroll
                    for (int n = 0; n < 2; ++n) *(pg8::f32x4*)(rowp + bj * 128 + n * 16) = acc[ai][bj][m][n]; }
    }
};
struct EpiRelu2 {
    static constexpr bool PERM = true, AFTER_DRAIN = false;
    bf16* O; int ldc;
    __device__ __forceinline__ void operator()(const pg8::f32x4 (&acc)[2][2][4][2], const pg8::Unit& u, int wr, int wc, int fr, int fq) const {
        const int row0 = u.pm * 256 + wr * 64 + fr, col0 = u.pn * 256 + wc * 32 + 8 * fq;
#pragma unroll
        for (int ai = 0; ai < 2; ++ai)
#pragma unroll
            for (int m = 0; m < 4; ++m) { bf16* rowp = O + (size_t)(row0 + ai * 128 + m * 16) * ldc + col0;
#pragma unroll
                for (int bj = 0; bj < 2; ++bj) { pg8::f32x4 v0 = acc[ai][bj][m][0], v1 = acc[ai][bj][m][1];
#pragma unroll
                    for (int e = 0; e < 4; ++e) { const float a = fmaxf(v0[e], 0.f), b = fmaxf(v1[e], 0.f); v0[e] = a * a; v1[e] = b * b; }
                    pg8::u32x4 w; w.x = pg8::cvt_pk_bf16(v0[0], v0[1]); w.y = pg8::cvt_pk_bf16(v0[2], v0[3]); w.z = pg8::cvt_pk_bf16(v1[0], v1[1]); w.w = pg8::cvt_pk_bf16(v1[2], v1[3]);
                    *(pg8::u32x4*)(rowp + bj * 128) = w; } }
    }
};
__device__ __forceinline__ void rowwise_resid(Frame& F, const float* xin, const float* r, const float* g, int gt_off, float* xo, bf16* H2, const float* g2, int sh_off, int sc_off) {
    const int gw = F.vcu * NWAVES + F.wave, NGW = F.G * NWAVES; const float* mod = (const float*)(F.ws + WS_MOD);
    for (int m = gw; m < ML; m += NGW) {
        const float* mr = mod + (size_t)(m >> 12) * 6 * D;
        const GAS f32x4* rp = (const GAS f32x4*)(r + (size_t)m * D) + F.lane; const GAS f32x4* xp = (const GAS f32x4*)(xin + (size_t)m * D) + F.lane;
        f32x4 v[4], xv[4]; float s = 0.f;
#pragma unroll
        for (int j = 0; j < 4; ++j) { v[j] = rp[64 * j]; xv[j] = xp[64 * j]; s += (v[j].x * v[j].x + v[j].y * v[j].y) + (v[j].z * v[j].z + v[j].w * v[j].w); }
        const float inv = 1.0f / sqrtf(wave_sum(s) * (1.f / D) + EPS); float s2 = 0.f;
        GAS f32x4* op = (GAS f32x4*)(xo + (size_t)m * D) + F.lane;
#pragma unroll
        for (int j = 0; j < 4; ++j) { const int col = 4 * F.lane + 256 * j; const f32x4 gg = *(const f32x4*)(g + col), gt = *(const f32x4*)(mr + gt_off + col);
            xv[j] = xv[j] + gt * (v[j] * inv * gg); op[64 * j] = xv[j]; s2 += (xv[j].x * xv[j].x + xv[j].y * xv[j].y) + (xv[j].z * xv[j].z + xv[j].w * xv[j].w); }
        if (H2) { const float inv2 = 1.0f / sqrtf(wave_sum(s2) * (1.f / D) + EPS); GAS v2u* o8 = (GAS v2u*)(H2 + (size_t)m * D) + F.lane;
#pragma unroll
            for (int j = 0; j < 4; ++j) { const int col = 4 * F.lane + 256 * j; const f32x4 gg = *(const f32x4*)(g2 + col), sh = *(const f32x4*)(mr + sh_off + col), sc = *(const f32x4*)(mr + sc_off + col);
                const f32x4 h = (xv[j] * inv2 * gg) * (sc + 1.0f) + sh; o8[64 * j] = (v2u){pk2(h.x, h.y), pk2(h.z, h.w)}; } }
    }
}
__device__ __forceinline__ void w2_transpose(Frame& F) {
    LAS float* scr = (LAS float*)(F.lds + F.wave * 8704); const int gw = F.vcu * NWAVES + F.wave, NGW = F.G * NWAVES;
    bf16* W2T = (bf16*)(F.ws + WS_W2T);
    for (int it = gw; it < 64 * 32; it += NGW) { const int kb = it / 32, nb = it % 32; p0_transpose_item(F.w2, D, 64 * kb, 32 * nb, W2T, FF, 32 * nb, scr, F.lane); }
}
namespace hs2 {
constexpr int KE0 = 0, KE1 = 16384, VA0 = 32768, VA1 = 49152;
constexpr int QT = 0, KT = 16384, VS0 = 32768, VS1 = 49152, AI = 65536, STI = 73728;
constexpr int NITEMS = 256, GSTEPS = 17;
}
constexpr size_t WS_SL0 = 100 * MiB;
constexpr size_t DO_SL1 = 57 * MiB;
constexpr size_t WS_BS = WS_LA;
__device__ __forceinline__ void tr_frag2(unsigned a0, unsigned a1, unsigned b0, unsigned b1, bf16x8& fa, bf16x8& fb) {
    v2u r0, r1, r2, r3;
    asm volatile("ds_read_b64_tr_b16 %0, %4\n\tds_read_b64_tr_b16 %1, %5\n\tds_read_b64_tr_b16 %2, %6\n\tds_read_b64_tr_b16 %3, %7\n\ts_waitcnt lgkmcnt(0)"
                 : "=&v"(r0), "=&v"(r1), "=&v"(r2), "=&v"(r3) : "v"(a0), "v"(a1), "v"(b0), "v"(b1) : "memory");
    v4u w; w.x = r0.x; w.y = r0.y; w.z = r1.x; w.w = r1.y; fa = __builtin_bit_cast(bf16x8, w);
    w.x = r2.x; w.y = r2.y; w.z = r3.x; w.w = r3.y; fb = __builtin_bit_cast(bf16x8, w);
}
__device__ __forceinline__ void p7_hgrn_scan2(Frame& F, const XcdBarrier& bar) {
    using namespace hs2;
    const bf16* Zh = (const bf16*)(F.ws + WS_ZH); const float* lbp = (const float*)(F.ws + WS_LB);
    float* BS = (float*)(F.ws + WS_BS);
    LAS unsigned char* L = F.lds; const unsigned LB = (unsigned)(unsigned long long)F.lds;
    const int wave = F.wave;
    for (int item = F.vcu; item < NITEMS; item += F.G) {
        int tid = F.tid; asm volatile("" : "+v"(tid));
        const int lane = tid & 63, fr = lane & 15, fq = lane >> 4, cp = lane & 7, tg = lane >> 3;
        const int grp = item & 3, dir = (item >> 2) & 1, h = (item >> 3) & 7, b = item >> 6;
        if (grp == 3) continue;
        const int c0 = 16 * wave + 2 * cp;
        const float lb0 = lbp[dir * 1024 + h * 128 + c0], lb1 = lbp[dir * 1024 + h * 128 + c0 + 1];
        pg8::f32x4 Sacc[8]; float bs[4] = {0.f, 0.f, 0.f, 0.f};
#pragma unroll
        for (int tv = 0; tv < 8; ++tv) Sacc[tv] = (pg8::f32x4){0.f, 0.f, 0.f, 0.f};
        __syncthreads();
        unsigned pf[8]; v4u pv[2];
#define H1_ISSUE(s_) do { const int nm_ = dir == 0 ? (s_) : ((s_) < 4 ? 3 - (s_) : 67 - ((s_) - 4)); const int tk0_ = chunk_tok0(b, nm_); \
        _Pragma("unroll") for (int i = 0; i < 8; ++i) { const int t = 8 * tg + i; pf[i] = *(const GAS unsigned*)(Zh + (size_t)(tk0_ + (dir == 0 ? t : 63 - t)) * 4096 + dir * 1024 + h * 128 + c0); } \
        _Pragma("unroll") for (int k = 0; k < 2; ++k) { const int q = tid + 512 * k, j = q >> 4, ch = q & 15; pv[k] = *(const GAS v4u*)(Zh + (size_t)(tk0_ + (dir == 0 ? j : 63 - j)) * 4096 + 3072 + h * 128 + ch * 8); } } while (0)
        const int s_begin = grp * GSTEPS;
        H1_ISSUE(s_begin);
        for (int s = s_begin; s < s_begin + GSTEPS; ++s) {
            const int KE = (s & 1) ? KE1 : KE0, VA = (s & 1) ? VA1 : VA0;
            float cum0[8], cum1[8], kk0[8], kk1[8]; float x0 = 0.f, x1 = 0.f;
#pragma unroll
            for (int i = 0; i < 8; ++i) { const float z0 = bflo(pf[i]), z1 = bfhi(pf[i]);
                const float em0 = __expf(-z0), em1 = __expf(-z1), sg0 = frcp(1.f + em0), sg1 = frcp(1.f + em1);
                x0 += __logf(lb0 + (1.f - lb0) * sg0); x1 += __logf(lb1 + (1.f - lb1) * sg1); cum0[i] = x0; cum1[i] = x1;
                kk0[i] = (1.f - lb0) * em0 * sg0; kk1[i] = (1.f - lb1) * em1 * sg1; }
            float in0 = x0, in1 = x1;
            { float t0 = __shfl_up(in0, 8), t1 = __shfl_up(in1, 8); if (tg >= 1) { in0 += t0; in1 += t1; }
              t0 = __shfl_up(in0, 16); t1 = __shfl_up(in1, 16); if (tg >= 2) { in0 += t0; in1 += t1; }
              t0 = __shfl_up(in0, 32); t1 = __shfl_up(in1, 32); if (tg >= 4) { in0 += t0; in1 += t1; } }
            const float bl0 = __shfl(in0, 56 + cp), bl1 = __shfl(in1, 56 + cp), ex0 = in0 - x0, ex1 = in1 - x1;
#pragma unroll
            for (int i = 0; i < 8; ++i) { const int t = 8 * tg + i;
                *(LAS unsigned*)(L + KE + off_b(t, 2 * wave + (cp >> 2)) + (cp & 3) * 4) = pk2(kk0[i] * __expf(bl0 - (ex0 + cum0[i])), kk1[i] * __expf(bl1 - (ex1 + cum1[i]))); }
#pragma unroll
            for (int k = 0; k < 2; ++k) { const int q = tid + 512 * k, j = q >> 4, ch = q & 15; *(LAS v4u*)(L + VA + off_b(j, ch)) = pv[k]; }
            float ebl[4];
            { const float a0 = __shfl(bl0, 2 * fq), a1 = __shfl(bl1, 2 * fq), b0 = __shfl(bl0, 2 * fq + 1), b1 = __shfl(bl1, 2 * fq + 1);
              bs[0] += a0; bs[1] += a1; bs[2] += b0; bs[3] += b1; ebl[0] = __expf(a0); ebl[1] = __expf(a1); ebl[2] = __expf(b0); ebl[3] = __expf(b1); }
            __syncthreads();
            if (s + 1 < s_begin + GSTEPS) H1_ISSUE(s + 1);
            bf16x8 kf[2]; tr_frag2(LB + KE + tr_addr_b(lane, wave, 0, 0), LB + KE + tr_addr_b(lane, wave, 0, 1), LB + KE + tr_addr_b(lane, wave, 1, 0), LB + KE + tr_addr_b(lane, wave, 1, 1), kf[0], kf[1]);
#pragma unroll
            for (int tv = 0; tv < 8; ++tv) { bf16x8 vf[2]; tr_frag2(LB + VA + tr_addr_b(lane, tv, 0, 0), LB + VA + tr_addr_b(lane, tv, 0, 1), LB + VA + tr_addr_b(lane, tv, 1, 0), LB + VA + tr_addr_b(lane, tv, 1, 1), vf[0], vf[1]);
                pg8::f32x4 p = {0.f, 0.f, 0.f, 0.f};
                p = __builtin_amdgcn_mfma_f32_16x16x32_bf16(kf[0], vf[0], p, 0, 0, 0); p = __builtin_amdgcn_mfma_f32_16x16x32_bf16(kf[1], vf[1], p, 0, 0, 0);
#pragma unroll
                for (int e = 0; e < 4; ++e) Sacc[tv][e] = ebl[e] * Sacc[tv][e] + p[e]; }
        }
#undef H1_ISSUE
        const int chain = b * NH + h;
        float* sl = (float*)(dir == 0 ? F.ws + WS_SL0 : F.dob + DO_SL1) + (size_t)(chain * 3 + grp) * 16384;
#pragma unroll
        for (int tv = 0; tv < 8; ++tv) *(pg8::f32x4*)(sl + ((wave * 8 + tv) * 64 + lane) * 4) = Sacc[tv];
        if (fr == 0) { float* bp = BS + (size_t)((dir * 32 + chain) * 3 + grp) * 128 + 16 * wave + 4 * fq; *(f32x4*)bp = (f32x4){bs[0], bs[1], bs[2], bs[3]}; }
    }
    xcd_barrier(bar);
    for (int item = F.vcu; item < NITEMS; item += F.G) {
        int tid = F.tid; asm volatile("" : "+v"(tid));
        const int lane = tid & 63, fr = lane & 15, fq = lane >> 4, cp = lane & 7, tg = lane >> 3;
        const int grp = item & 3, dir = (item >> 2) & 1, h = (item >> 3) & 7, b = item >> 6, chain = b * NH + h;
        const int c0 = 16 * wave + 2 * cp;
        bf16* Oout = (bf16*)(F.ws + (dir == 0 ? WS_OBF : WS_OBB));
        const float lb0 = lbp[dir * 1024 + h * 128 + c0], lb1 = lbp[dir * 1024 + h * 128 + c0 + 1];
        pg8::f32x4 Sacc[8];
#pragma unroll
        for (int tv = 0; tv < 8; ++tv) Sacc[tv] = (pg8::f32x4){0.f, 0.f, 0.f, 0.f};
        for (int g = 0; g < grp; ++g) {
            const float* sl = (const float*)(dir == 0 ? F.ws + WS_SL0 : F.dob + DO_SL1) + (size_t)(chain * 3 + g) * 16384;
            const f32x4 bd = *(const f32x4*)(BS + (size_t)((dir * 32 + chain) * 3 + g) * 128 + 16 * wave + 4 * fq);
            const float d[4] = {__expf(bd.x), __expf(bd.y), __expf(bd.z), __expf(bd.w)};
#pragma unroll
            for (int tv = 0; tv < 8; ++tv) { const pg8::f32x4 a = *(const pg8::f32x4*)(sl + ((wave * 8 + tv) * 64 + lane) * 4);
#pragma unroll
                for (int e = 0; e < 4; ++e) Sacc[tv][e] = d[e] * Sacc[tv][e] + a[e]; } }
        __syncthreads();
        unsigned pf[8], pqb[8]; v4u pv[2];
#define H2_ISSUE(s_) do { const int nm_ = dir == 0 ? (s_) : ((s_) < 4 ? 3 - (s_) : 67 - ((s_) - 4)); const int tk0_ = chunk_tok0(b, nm_); \
        _Pragma("unroll") for (int i = 0; i < 8; ++i) { const int t = 8 * tg + i; const size_t ro = (size_t)(tk0_ + (dir == 0 ? t : 63 - t)) * 4096; \
            pf[i] = *(const GAS unsigned*)(Zh + ro + dir * 1024 + h * 128 + c0); pqb[i] = *(const GAS unsigned*)(Zh + ro + 2048 + h * 128 + c0); } \
        _Pragma("unroll") for (int k = 0; k < 2; ++k) { const int q = tid + 512 * k, j = q >> 4, ch = q & 15; pv[k] = *(const GAS v4u*)(Zh + (size_t)(tk0_ + (dir == 0 ? j : 63 - j)) * 4096 + 3072 + h * 128 + ch * 8); } } while (0)
        const int s_begin = grp * GSTEPS;
        H2_ISSUE(s_begin);
        for (int s = s_begin; s < s_begin + GSTEPS; ++s) {
            const int nm = dir == 0 ? s : (s < 4 ? 3 - s : 67 - (s - 4)); const int tok0 = chunk_tok0(b, nm);
            const int VS = (s & 1) ? VS1 : VS0;
            float ebl[4], ebd[4];
            { float cum0[8], cum1[8], kk0[8], kk1[8], q0[8], q1[8]; float x0 = 0.f, x1 = 0.f;
#pragma unroll
              for (int i = 0; i < 8; ++i) { const float z0 = bflo(pf[i]), z1 = bfhi(pf[i]);
                  const float em0 = __expf(-z0), em1 = __expf(-z1), sg0 = frcp(1.f + em0), sg1 = frcp(1.f + em1);
                  x0 += __logf(lb0 + (1.f - lb0) * sg0); x1 += __logf(lb1 + (1.f - lb1) * sg1); cum0[i] = x0; cum1[i] = x1;
                  kk0[i] = (1.f - lb0) * em0 * sg0; kk1[i] = (1.f - lb1) * em1 * sg1;
                  const float y0 = bflo(pqb[i]), y1 = bfhi(pqb[i]); q0[i] = y0 * frcp(1.f + __expf(-y0)) * 0.08838834764831845f; q1[i] = y1 * frcp(1.f + __expf(-y1)) * 0.08838834764831845f; }
              float in0 = x0, in1 = x1;
              { float t0 = __shfl_up(in0, 8), t1 = __shfl_up(in1, 8); if (tg >= 1) { in0 += t0; in1 += t1; }
                t0 = __shfl_up(in0, 16); t1 = __shfl_up(in1, 16); if (tg >= 2) { in0 += t0; in1 += t1; }
                t0 = __shfl_up(in0, 32); t1 = __shfl_up(in1, 32); if (tg >= 4) { in0 += t0; in1 += t1; } }
              const float bl0 = __shfl(in0, 56 + cp), bl1 = __shfl(in1, 56 + cp), br0 = __shfl(in0, 24 + cp), br1 = __shfl(in1, 24 + cp);
              const float ex0 = in0 - x0 - br0, ex1 = in1 - x1 - br1;
#pragma unroll
              for (int i = 0; i < 8; ++i) { const int t = 8 * tg + i; const float d0 = ex0 + cum0[i], d1 = ex1 + cum1[i];
                  *(LAS unsigned*)(L + QT + off_b(t, 2 * wave + (cp >> 2)) + (cp & 3) * 4) = pk2(q0[i] * __expf(d0), q1[i] * __expf(d1));
                  *(LAS unsigned*)(L + KT + off_b(t, 2 * wave + (cp >> 2)) + (cp & 3) * 4) = pk2(kk0[i] * __expf(-d0), kk1[i] * __expf(-d1)); }
#pragma unroll
              for (int k = 0; k < 2; ++k) { const int q = tid + 512 * k, j = q >> 4, ch = q & 15; *(LAS v4u*)(L + VS + off_b(j, ch)) = pv[k]; }
              const float la0 = __shfl(bl0, 2 * fq), la1 = __shfl(bl1, 2 * fq), lb0_ = __shfl(bl0, 2 * fq + 1), lb1_ = __shfl(bl1, 2 * fq + 1);
              const float ra0 = __shfl(br0, 2 * fq), ra1 = __shfl(br1, 2 * fq), rb0 = __shfl(br0, 2 * fq + 1), rb1 = __shfl(br1, 2 * fq + 1);
              const float ebr[4] = {__expf(ra0), __expf(ra1), __expf(rb0), __expf(rb1)};
              ebl[0] = __expf(la0); ebl[1] = __expf(la1); ebl[2] = __expf(lb0_); ebl[3] = __expf(lb1_);
              ebd[0] = __expf(la0 - ra0); ebd[1] = __expf(la1 - ra1); ebd[2] = __expf(lb0_ - rb0); ebd[3] = __expf(lb1_ - rb1);
              const int kc = 16 * wave + 4 * fq;
#pragma unroll
              for (int tv = 0; tv < 8; ++tv) { const int v = 16 * tv + fr;
                  *(LAS v2u*)(L + STI + off_b(v, kc >> 3) + (kc & 4) * 2) = (v2u){pk2(Sacc[tv][0] * ebr[0], Sacc[tv][1] * ebr[1]), pk2(Sacc[tv][2] * ebr[2], Sacc[tv][3] * ebr[3])}; } }
            __syncthreads();
            if (s + 1 < s_begin + GSTEPS) H2_ISSUE(s + 1);
#pragma unroll
            for (int tt = 0; tt < 2; ++tt) { const int t = 2 * wave + tt, ts = t >> 2, ti = t & 3;
                pg8::f32x4 acc = {0.f, 0.f, 0.f, 0.f};
                if (ts <= ti) {
#pragma unroll
                    for (int ks = 0; ks < 4; ++ks) { const bf16x8 fa = *(const LAS bf16x8*)(L + KT + off_b(16 * ts + fr, 4 * ks + fq)), fb = *(const LAS bf16x8*)(L + QT + off_b(16 * ti + fr, 4 * ks + fq));
                        acc = __builtin_amdgcn_mfma_f32_16x16x32_bf16(fa, fb, acc, 0, 0, 0); } }
                const int i = 16 * ti + fr, j0 = 16 * ts + 4 * fq; float o[4];
#pragma unroll
                for (int e = 0; e < 4; ++e) o[e] = (j0 + e <= i) ? acc[e] : 0.f;
                *(LAS v2u*)(L + AI + off64(i, j0 >> 3) + (j0 & 4) * 2) = (v2u){pk2(o[0], o[1]), pk2(o[2], o[3])}; }
            pg8::f32x4 oacc[4];
#pragma unroll
            for (int ti = 0; ti < 4; ++ti) oacc[ti] = (pg8::f32x4){0.f, 0.f, 0.f, 0.f};
#pragma unroll
            for (int ks = 0; ks < 4; ++ks) { const bf16x8 fa = *(const LAS bf16x8*)(L + STI + off_b(16 * wave + fr, 4 * ks + fq));
#pragma unroll
                for (int ti = 0; ti < 4; ++ti) { const bf16x8 fb = *(const LAS bf16x8*)(L + QT + off_b(16 * ti + fr, 4 * ks + fq)); oacc[ti] = __builtin_amdgcn_mfma_f32_16x16x32_bf16(fa, fb, oacc[ti], 0, 0, 0); } }
            bf16x8 vw[2];
            { bf16x8 kf[2]; tr_frag2(LB + KT + tr_addr_b(lane, wave, 0, 0), LB + KT + tr_addr_b(lane, wave, 0, 1), LB + KT + tr_addr_b(lane, wave, 1, 0), LB + KT + tr_addr_b(lane, wave, 1, 1), kf[0], kf[1]);
#pragma unroll
              for (int tv = 0; tv < 8; ++tv) { bf16x8 vf[2]; tr_frag2(LB + VS + tr_addr_b(lane, tv, 0, 0), LB + VS + tr_addr_b(lane, tv, 0, 1), LB + VS + tr_addr_b(lane, tv, 1, 0), LB + VS + tr_addr_b(lane, tv, 1, 1), vf[0], vf[1]);
                  if (tv == wave) { vw[0] = vf[0]; vw[1] = vf[1]; }
                  pg8::f32x4 p = {0.f, 0.f, 0.f, 0.f};
                  p = __builtin_amdgcn_mfma_f32_16x16x32_bf16(kf[0], vf[0], p, 0, 0, 0); p = __builtin_amdgcn_mfma_f32_16x16x32_bf16(kf[1], vf[1], p, 0, 0, 0);
#pragma unroll
                  for (int e = 0; e < 4; ++e) Sacc[tv][e] = ebl[e] * Sacc[tv][e] + ebd[e] * p[e]; } }
            __syncthreads();
#pragma unroll
            for (int ks = 0; ks < 2; ++ks)
#pragma unroll
                for (int ti = 0; ti < 4; ++ti) { const bf16x8 fb = *(const LAS bf16x8*)(L + AI + off64(16 * ti + fr, 4 * ks + fq)); oacc[ti] = __builtin_amdgcn_mfma_f32_16x16x32_bf16(vw[ks], fb, oacc[ti], 0, 0, 0); }
            if (nm >= 4) {
#pragma unroll
                for (int ti = 0; ti < 4; ++ti) { const int i = 16 * ti + fr, v0 = 16 * wave + 4 * fq; const int tok = tok0 + (dir == 0 ? i : 63 - i);
                    *(GAS v2u*)(Oout + (size_t)tok * 1024 + h * 128 + v0) = (v2u){pk2(oacc[ti][0], oacc[ti][1]), pk2(oacc[ti][2], oacc[ti][3])}; } }
        }
#undef H2_ISSUE
    }
}
constexpr int NPH = 16;
#ifndef REPP
#define REPP -1
#endif
#define NREP(k) ((REPP) == (k) ? 2 : 1)
__global__ void __launch_bounds__(NTHR, 2) mk_fwd(Args args) {
    extern __shared__ __attribute__((aligned(16))) unsigned char lds[];
    Frame F;
    F.lds = (LAS unsigned char*)lds; F.MISC = (volatile LAS unsigned*)(F.lds + MISC_OFF);
    F.tid = threadIdx.x; F.lane = F.tid & 63; F.wave = __builtin_amdgcn_readfirstlane(F.tid >> 6);
    F.G = gridDim.x; { const int bx = blockIdx.x; F.vcu = (F.G % 8 == 0) ? (bx % 8) * (F.G / 8) + bx / 8 : bx; }
    F.ws = args.ws; F.out = args.out; F.dob = (unsigned char*)args.out; F.ctl = (gu32*)(args.ws + WS_CTL);
    F.x = args.in[0]; F.c = args.in[1]; F.ctx = args.in[2]; F.c_ctx = args.in[3]; F.w_ada = args.in[4]; F.b_ada = args.in[5]; F.norm_g = args.in[6]; F.w_in = args.in[7];
    F.conv_w = args.in[8]; F.a_log = args.in[9]; F.dt_bias = args.in[10]; F.gdn_nw = args.in[11]; F.lb_logits = args.in[12]; F.hgrn_nw = args.in[13]; F.w_ba = args.in[14];
    F.w_bb = args.in[15]; F.w_out = args.in[16]; F.w1 = args.in[17]; F.w2 = args.in[18];
    for (int u = F.tid; u < (LDS_BYTES - MISC_OFF) / 4; u += NTHR) ((LAS unsigned*)(F.lds + MISC_OFF))[u] = 0u;
    __syncthreads();
    XcdBarrier bar = xcd_barrier_post((unsigned*)(F.ctl + CW_BAR) + args.li * XCD_BAR_WORDS, F.MISC + 8);
    const int lo = args.ph_lo, hi = args.ph_hi;
#define IN(k) (lo <= (k) && (k) < hi)
#define SEAM(k) do { if ((k) + 1 < hi) xcd_barrier(bar); } while (0)
    bf16* H = (bf16*)(F.dob + DO_H); bf16* WinT = (bf16*)(F.dob + DO_WIN);
    if (IN(0)) { p0_prologue(F); SEAM(0); }
    if (IN(1)) { p1_hrows(F); SEAM(1); }
    if (IN(2)) {
        pg8::Gemm g{H, WinT + (size_t)R_QKV * D, MR, N_G1, D}; pg8::StaticOrder S; S.init(MR, N_G1, F.G, (int)blockIdx.x);
        EpiG1 E{(bf16*)(F.ws + WS_ZQ), (float*)(F.ws + WS_LA), (float*)(F.ws + WS_BE), F.a_log, F.dt_bias};
        pg8::gemm_phase<EpiG1, pg8::StaticOrder, true, true>(F.lds, g, S, E);
        SEAM(2);
    }
    if (IN(3)) { for (int rep = 0; rep < NREP(3); ++rep) p3_gdn_prep(F); SEAM(3); }
    if (IN(4)) { for (int rep = 0; rep < NREP(4); ++rep) p4_gdn_scan(F); SEAM(4); }
    if (IN(5)) { combine_norm(F, (const bf16*)(F.ws + WS_OAF), (const bf16*)(F.ws + WS_OAB), F.gdn_nw, (bf16*)(F.ws + WS_NA)); }
    if (IN(6)) {
        pg8::Gemm g{H, WinT + (size_t)R_G2 * D, MR, N_G2, D}; pg8::StaticOrder S; S.init(MR, N_G2, F.G, (int)blockIdx.x);
        EpiStore E{(bf16*)(F.ws + WS_ZH), N_G2};
        pg8::gemm_phase<EpiStore, pg8::StaticOrder, true, true>(F.lds, g, S, E);
        SEAM(6);
    }
    if (IN(7)) { for (int rep = 0; rep < NREP(7); ++rep) p7_hgrn_scan2(F, bar); SEAM(7); }
    if (IN(8)) { combine_norm(F, (const bf16*)(F.ws + WS_OBF), (const bf16*)(F.ws + WS_OBB), F.hgrn_nw, (bf16*)(F.ws + WS_NB)); w2_transpose(F); SEAM(8); }
    bf16* WaT = (bf16*)(F.ws + WS_WSM); bf16* WbT = WaT + (size_t)D * D; bf16* WoT = WbT + (size_t)D * D; bf16* W1T = WoT + (size_t)D * D;
    if (IN(9)) {
        pg8::Gemm g{H, WinT + (size_t)R_GA * D, ML, N_G3, D}; pg8::StaticOrder S; S.init(ML, N_G3, F.G, (int)blockIdx.x);
        EpiG3 E{F.ws};
        pg8::gemm_phase<EpiG3, pg8::StaticOrder, true, true>(F.lds, g, S, E);
        SEAM(9);
    }
    if (IN(10)) {
        pg8::StaticOrder S; S.init(ML, D, F.G, (int)blockIdx.x);
        { pg8::Gemm g{(const bf16*)(F.ws + WS_NA), WaT, ML, D, D}; EpiMerge<0> E{(const bf16*)(F.ws + WS_SG), (float*)(F.ws + WS_TMP), (bf16*)(F.ws + WS_MB)};
          pg8::gemm_phase<EpiMerge<0>, pg8::StaticOrder, true, true>(F.lds, g, S, E); }
        __syncthreads();
        { pg8::Gemm g{(const bf16*)(F.ws + WS_NB), WbT, ML, D, D}; EpiMerge<1> E{(const bf16*)(F.ws + WS_SG), (float*)(F.ws + WS_TMP), (bf16*)(F.ws + WS_MB)};
          pg8::gemm_phase<EpiMerge<1>, pg8::StaticOrder, true, true>(F.lds, g, S, E); }
        SEAM(10);
    }
    if (IN(11)) {
        pg8::Gemm g{(const bf16*)(F.ws + WS_MB), WoT, ML, D, D}; pg8::StaticOrder S; S.init(ML, D, F.G, (int)blockIdx.x);
        EpiF32S E{(float*)(F.ws + WS_TMP), D};
        pg8::gemm_phase<EpiF32S, pg8::StaticOrder, true, true>(F.lds, g, S, E);
        SEAM(11);
    }
    if (IN(12)) { rowwise_resid(F, F.x, (const float*)(F.ws + WS_TMP), F.norm_g + D, 2 * D, F.out, (bf16*)(F.ws + WS_H2), F.norm_g + 2 * D, 3 * D, 4 * D); SEAM(12); }
    if (IN(13)) {
        pg8::Gemm g{(const bf16*)(F.ws + WS_H2), W1T, ML, FF, D}; pg8::StaticOrder S; S.init(ML, FF, F.G, (int)blockIdx.x);
        EpiRelu2 E{(bf16*)(F.ws + WS_HID), FF};
        pg8::gemm_phase<EpiRelu2, pg8::StaticOrder, true, true>(F.lds, g, S, E);
        SEAM(13);
    }
    if (IN(14)) {
        pg8::Gemm g{(const bf16*)(F.ws + WS_HID), (const bf16*)(F.ws + WS_W2T), ML, D, FF}; pg8::StaticOrder S; S.init(ML, D, F.G, (int)blockIdx.x);
        EpiF32S E{(float*)(F.ws + WS_TMP), D};
        pg8::gemm_phase<EpiF32S, pg8::StaticOrder, true, true>(F.lds, g, S, E);
        SEAM(14);
    }
    if (IN(15)) { rowwise_resid(F, F.out, (const float*)(F.ws + WS_TMP), F.norm_g + 3 * D, 5 * D, F.out, nullptr, nullptr, 0, 0); }
#undef IN
#undef SEAM
}
}
static int fk_grid(hipStream_t) {
    static int grid = 0;
    if (grid == 0) {
        int dev = 0, cus = 0, per_cu = 0;
        if (hipGetDevice(&dev) != hipSuccess || hipDeviceGetAttribute(&cus, hipDeviceAttributeMultiprocessorCount, dev) != hipSuccess) { grid = -1; return grid; }
        if (hipFuncSetAttribute((const void*)fk::mk_fwd, hipFuncAttributeMaxDynamicSharedMemorySize, fk::LDS_BYTES) != hipSuccess) { fprintf(stderr, "hipFuncSetAttribute failed\n"); grid = -1; return grid; }
        if (hipOccupancyMaxActiveBlocksPerMultiprocessor(&per_cu, (const void*)fk::mk_fwd, fk::NTHR, fk::LDS_BYTES) != hipSuccess || per_cu < 1) { fprintf(stderr, "occupancy query: %d blocks/CU\n", per_cu); (void)hipGetLastError(); grid = -1; return grid; }
        grid = cus;
    }
    return grid;
}
static void fk_launch(const fk::Args& a0, int lo, int hi, int li, int grid, hipStream_t stream) {
    fk::Args a = a0; a.ph_lo = lo; a.ph_hi = hi; a.li = li; a.pad = 0;
    hipLaunchKernelGGL(fk::mk_fwd, dim3(grid), dim3(fk::NTHR), fk::LDS_BYTES, stream, a);
}
extern "C" void kernel_launch(void* const* d_in, const int* in_sizes, int n_in, void* d_out, int out_size, void* d_ws, size_t ws_size, hipStream_t stream) {
    const Ins I = get_ins(d_in); float* out = (float*)d_out; char* ws = (char*)d_ws;
    if (n_in != 19 || ws_size < fk::WS_END || out_size != fk::ML * fk::D) { fprintf(stderr, "kernel_launch: unexpected sizes\n"); return; }
#if MODE == 0
    OB B; if (!ob_carve(B, ws, ws_size)) return;
    oracle_pre(B, I, stream);
    for (int b = 0; b < nv::NB; ++b) oracle_batch(B, b, 99, I, out, stream);
#else
    const int grid = fk_grid(stream); if (grid < 0) return;
    (void)hipMemsetAsync(ws + fk::WS_CTL, 0, fk::CTL_ZERO_BYTES, stream);
    fk::Args a{}; for (int i = 0; i < 19; ++i) a.in[i] = (const float*)d_in[i]; a.out = out; a.ws = (unsigned char*)d_ws;
#if MODE == 2
    fk_launch(a, 0, fk::NPH, 0, grid, stream);
#elif MODE == 3
    for (int p = 0; p < fk::NPH; ++p) fk_launch(a, p, p + 1, p, grid, stream);
#else
    float* err = (float*)(ws + fk::WS_CTL) + fk::CW_ERR; int nerr = 0;
    const int MiB = 1 << 20;
#if DBG_STAGE == 1
    for (int p = 0; p < 3; ++p) fk_launch(a, p, p + 1, p, grid, stream);
    { OB B; if (!ob_carve(B, ws + (size_t)106 * MiB, (size_t)150 * MiB, 1)) { fprintf(stderr, "carve\n"); return; }
      oracle_pre(B, I, stream);
      for (int b = 0; b < nv::NB; ++b) { oracle_batch(B, b, 1, I, out, stream);
        hipLaunchKernelGGL(nv::k_cmp<unsigned short>, dim3(1024), dim3(256), 0, stream, (const unsigned short*)(ws + fk::WS_ZQ), 3072, 0, B.zbuf, 3072, b, 0, nv::ROWS, 3072, 0, err + 0);
        hipLaunchKernelGGL(nv::k_cmp<float>, dim3(64), dim3(256), 0, stream, (const float*)(ws + fk::WS_LA), 16, 0, B.la, 16, b, 0, nv::ROWS, 16, 0, err + 2);
        hipLaunchKernelGGL(nv::k_cmp<float>, dim3(64), dim3(256), 0, stream, (const float*)(ws + fk::WS_BE), 16, 0, B.be, 16, b, 0, nv::ROWS, 16, 0, err + 4); }
      nerr = 3; }
#endif
#if DBG_STAGE == 2
    for (int p = 0; p < 4; ++p) fk_launch(a, p, p + 1, p, grid, stream);
    { OB B{}; char* dob = (char*)d_out;
      B.hb = (float*)dob; B.zab = (float*)(dob + (size_t)17 * MiB); B.la = (float*)(dob + (size_t)18 * MiB); B.be = (float*)(dob + (size_t)19 * MiB); B.mod = (float*)(dob + (size_t)20 * MiB); B.lb = (float*)(dob + (size_t)21 * MiB);
      B.zbuf = (float*)(ws + (size_t)4 * MiB); B.qkvc = (float*)(ws + (size_t)55 * MiB);
      oracle_pre(B, I, stream);
      for (int b = 0; b < nv::NB; ++b) { oracle_batch(B, b, 2, I, out, stream);
        hipLaunchKernelGGL(nv::k_cmp<unsigned short>, dim3(1024), dim3(256), 0, stream, (const unsigned short*)(ws + fk::WS_QKVC), 3072, 0, B.qkvc, 3072, b, 0, nv::ROWS, 3072, 0, err + 0); }
      nerr = 1; }
#endif
#if DBG_STAGE == 3
    for (int p = 0; p < 5; ++p) fk_launch(a, p, p + 1, p, grid, stream);
    { OB B; if (!ob_carve(B, ws + (size_t)68 * MiB, (size_t)188 * MiB, 3)) { fprintf(stderr, "carve\n"); return; }
      oracle_pre(B, I, stream);
      for (int b = 0; b < nv::NB; ++b) { oracle_batch(B, b, 3, I, out, stream);
        hipLaunchKernelGGL(nv::k_cmp2, dim3(1024), dim3(256), 0, stream, (const unsigned short*)(ws + fk::WS_OAF), (const unsigned short*)(ws + fk::WS_OAB), 1024, B.oa, 1024, b, nv::T, 1024, err + 0); }
      nerr = 1; }
#endif
#if DBG_STAGE == 4
    for (int p = 0; p < 8; ++p) fk_launch(a, p, p + 1, p, grid, stream);
    { OB B; if (!ob_carve(B, ws + (size_t)100 * MiB, (size_t)156 * MiB, 4)) { fprintf(stderr, "carve\n"); return; }
      oracle_pre(B, I, stream);
      for (int b = 0; b < nv::NB; ++b) { oracle_batch(B, b, 4, I, out, stream);
        hipLaunchKernelGGL(nv::k_cmp2, dim3(1024), dim3(256), 0, stream, (const unsigned short*)(ws + fk::WS_OBF), (const unsigned short*)(ws + fk::WS_OBB), 1024, B.ob, 1024, b, nv::T, 1024, err + 0); }
      nerr = 1; }
#endif
    { OB B; if (!ob_carve(B, ws + (size_t)1 * MiB, ws_size - (size_t)1 * MiB)) { fprintf(stderr, "carve2\n"); return; }
      oracle_pre(B, I, stream);
      for (int b = 0; b < nv::NB; ++b) oracle_batch(B, b, 99, I, out, stream);
      hipLaunchKernelGGL(nv::k_scale_out, dim3(2048), dim3(256), 0, stream, out, (size_t)fk::ML * fk::D, err, nerr); }
#endif
#endif
}
```
